# Optimizing an MI355X kernel written in HIP

```python
import math
import jax, jax.numpy as jnp
from jax import lax
import numpy as np

D_MODEL = 4096
BATCH = 4
SEQ = 4096
DEPTH = 1

D_FF = 11008
D_SSM = D_MODEL // 2
SSM_GROUP = 16
N_SSM_GROUPS = D_SSM // SSM_GROUP
SSM_STATE = 64
DT_MIN = 0.001
DT_MAX = 0.1
D_CONV = D_MODEL // 2
CONV_WIDTH = 3
N_MEM = 256
N_XHEADS = 4
XHEAD_DIM = D_MODEL // N_XHEADS
MIX_IN_COLS = D_SSM + 3 * D_CONV + 2 * D_MODEL
MIX_SPLITS = (D_SSM, D_SSM + D_CONV, D_SSM + 2 * D_CONV, D_SSM + 3 * D_CONV,
              D_SSM + 3 * D_CONV + D_MODEL)
RMS_EPS = 1e-6

kernel_name = "hybrid_s5_shortconv_gated_macaron_xattn"


def rms_norm(x, g):
    xf = x.astype(jnp.float32)
    y = xf * lax.rsqrt(jnp.mean(xf * xf, axis=-1, keepdims=True) + RMS_EPS)
    return (y * g.astype(jnp.float32)).astype(x.dtype)


def swiglu(h, w_in, w_out):
    a, b = jnp.split(h @ w_in, 2, axis=-1)
    return (jax.nn.silu(a) * b) @ w_out


def _ssm_combine(e1, e2):
    a1, b1 = e1
    a2, b2 = e2
    return a1 * a2, a2 * b1 + b2


def s5_mixer(u, a_re, a_im, log_dt, b_re, b_im, c_re, c_im, d_skip):
    bsz, seq, _ = u.shape
    f32 = jnp.float32
    uf = u.astype(f32).reshape(bsz, seq, N_SSM_GROUPS, SSM_GROUP)
    lam = lax.complex(a_re.astype(f32), a_im.astype(f32))
    dt = jnp.exp(log_dt.astype(f32))[:, None]
    lam_bar = jnp.exp(lam * dt)
    b = lax.complex(b_re.astype(f32), b_im.astype(f32))
    b_bar = ((lam_bar - 1.0) / lam)[..., None] * b
    c = lax.complex(c_re.astype(f32), c_im.astype(f32))
    bu = jnp.einsum('blgh,gph->blgp', uf, b_bar)
    a_elems = jnp.broadcast_to(lam_bar, (1, seq) + lam_bar.shape)
    _, states = lax.associative_scan(_ssm_combine, (a_elems, bu), axis=1)
    y = jnp.einsum('blgp,ghp->blgh', states, c).real
    y = y.reshape(bsz, seq, D_SSM) + d_skip.astype(f32) * uf.reshape(bsz, seq, D_SSM)
    return y.astype(u.dtype)


def causal_depthwise_conv(z, w):
    k, c = w.shape
    rhs = w.astype(z.dtype)[:, None, :]
    return lax.conv_general_dilated(z, rhs, window_strides=(1,), padding=((k - 1, 0),),
                                    dimension_numbers=('NWC', 'WIO', 'NWC'),
                                    feature_group_count=c)


def cross_attention(hq, mkv, wq, wk, wv, wo):
    bsz, seq, _ = hq.shape
    n_mem = mkv.shape[1]
    q = (hq @ wq).reshape(bsz, seq, N_XHEADS, XHEAD_DIM)
    k = (mkv @ wk).reshape(bsz, n_mem, N_XHEADS, XHEAD_DIM)
    v = (mkv @ wv).reshape(bsz, n_mem, N_XHEADS, XHEAD_DIM)
    s = jnp.einsum('blhd,bmhd->bhlm', q, k).astype(jnp.float32) * (XHEAD_DIM ** -0.5)
    p = jax.nn.softmax(s, axis=-1).astype(v.dtype)
    o = jnp.einsum('bhlm,bmhd->blhd', p, v).reshape(bsz, seq, D_MODEL)
    return o @ wo


def setup_inputs(seed: int = 0) -> dict:
    key = jax.random.key(seed)
    ks = iter(jax.random.split(key, 40))
    f32 = jnp.float32

    def nrm(shape, scale):
        return jax.random.normal(next(ks), shape, f32) * scale

    def gain(shape):
        return 1.0 + 0.02 * jax.random.normal(next(ks), shape, f32)

    L, G, P, H = DEPTH, N_SSM_GROUPS, SSM_STATE, SSM_GROUP
    a_im_base = math.pi * jnp.arange(P, dtype=f32)
    return {
        "x": nrm((BATCH, SEQ, D_MODEL), 1.0),
        "mem": nrm((BATCH, N_MEM, D_MODEL), 1.0),
        "ffn1_norm": gain((L, D_MODEL)),
        "ffn1_w_in": nrm((L, D_MODEL, 2 * D_FF), D_MODEL ** -0.5),
        "ffn1_w_out": nrm((L, D_FF, D_MODEL), D_FF ** -0.5),
        "mix_norm": gain((L, D_MODEL)),
        "mix_w_in": nrm((L, D_MODEL, MIX_IN_COLS), D_MODEL ** -0.5),
        "ssm_a_re": -0.5 + nrm((L, G, P), 0.01),
        "ssm_a_im": a_im_base + nrm((L, G, P), 0.01),
        "ssm_log_dt": jax.random.uniform(next(ks), (L, G), f32,
                                         math.log(DT_MIN), math.log(DT_MAX)),
        "ssm_b_re": nrm((L, G, P, H), (2 * H) ** -0.5),
        "ssm_b_im": nrm((L, G, P, H), (2 * H) ** -0.5),
        "ssm_c_re": nrm((L, G, H, P), 1.0),
        "ssm_c_im": nrm((L, G, H, P), 1.0),
        "ssm_d": nrm((L, D_SSM), 1.0),
        "ssm_glu_w": nrm((L, D_SSM, 2 * D_MODEL), D_SSM ** -0.5),
        "conv_w": nrm((L, CONV_WIDTH, D_CONV), CONV_WIDTH ** -0.5),
        "conv_w_out": nrm((L, D_CONV, D_MODEL), D_CONV ** -0.5),
        "mix_w_out": nrm((L, D_MODEL, D_MODEL), D_MODEL ** -0.5),
        "xattn_norm": gain((L, D_MODEL)),
        "mem_norm": gain((L, D_MODEL)),
        "xattn_wq": nrm((L, D_MODEL, D_MODEL), D_MODEL ** -0.5),
        "xattn_wk": nrm((L, D_MODEL, D_MODEL), D_MODEL ** -0.5),
        "xattn_wv": nrm((L, D_MODEL, D_MODEL), D_MODEL ** -0.5),
        "xattn_wo": nrm((L, D_MODEL, D_MODEL), D_MODEL ** -0.5),
        "ffn2_norm": gain((L, D_MODEL)),
        "ffn2_w_in": nrm((L, D_MODEL, 2 * D_FF), D_MODEL ** -0.5),
        "ffn2_w_out": nrm((L, D_FF, D_MODEL), D_FF ** -0.5),
        "final_norm": gain((D_MODEL,)),
    }


def reference(x, mem, ffn1_norm, ffn1_w_in, ffn1_w_out, mix_norm, mix_w_in,
              ssm_a_re, ssm_a_im, ssm_log_dt, ssm_b_re, ssm_b_im, ssm_c_re, ssm_c_im,
              ssm_d, ssm_glu_w, conv_w, conv_w_out, mix_w_out,
              xattn_norm, mem_norm, xattn_wq, xattn_wk, xattn_wv, xattn_wo,
              ffn2_norm, ffn2_w_in, ffn2_w_out, final_norm):
    h = x
    for l in range(DEPTH):
        h = h + 0.5 * swiglu(rms_norm(h, ffn1_norm[l]), ffn1_w_in[l], ffn1_w_out[l])

        u = rms_norm(h, mix_norm[l])
        u_ssm, cb, cc, ch, g_a, g_b = jnp.split(u @ mix_w_in[l], MIX_SPLITS, axis=-1)

        ys = jax.nn.gelu(s5_mixer(u_ssm, ssm_a_re[l], ssm_a_im[l], ssm_log_dt[l],
                                  ssm_b_re[l], ssm_b_im[l], ssm_c_re[l], ssm_c_im[l],
                                  ssm_d[l]), approximate=False)
        val, gl = jnp.split(ys @ ssm_glu_w[l], 2, axis=-1)
        y_a = val * jax.nn.sigmoid(gl)

        y_b = (cb * causal_depthwise_conv(cc * ch, conv_w[l])) @ conv_w_out[l]

        merged = jax.nn.sigmoid(g_a) * y_a + jax.nn.sigmoid(g_b) * y_b
        h = h + merged @ mix_w_out[l]

        h = h + cross_attention(rms_norm(h, xattn_norm[l]), rms_norm(mem, mem_norm[l]),
                                xattn_wq[l], xattn_wk[l], xattn_wv[l], xattn_wo[l])

        h = h + 0.5 * swiglu(rms_norm(h, ffn2_norm[l]), ffn2_w_in[l], ffn2_w_out[l])
    return rms_norm(h, final_norm)
```

```cpp
#include <hip/hip_runtime.h>
#include <cstdio>
#include <cstdint>

#ifndef MK_ONE_LAUNCH
#define MK_ONE_LAUNCH 1
#endif
#ifndef MK_I8_FFN
#define MK_I8_FFN 3
#endif
#ifndef MK_I8_MIX
#define MK_I8_MIX 1
#endif
#ifndef MK_SLABQ
#define MK_SLABQ 1
#endif
#ifndef MK_I8_KV
#define MK_I8_KV 1
#endif
#ifndef MK_XF32
#define MK_XF32 1
#endif
#ifndef MK_FP8_ATTN
#define MK_FP8_ATTN 0
#endif
#ifndef MK_FP8_GATES
#define MK_FP8_GATES 1
#endif

#define GAS __attribute__((address_space(1)))
#define LAS __attribute__((address_space(3)))
typedef unsigned short bf16;
typedef short bf16x8 __attribute__((ext_vector_type(8)));
typedef float f32x4 __attribute__((ext_vector_type(4)));
typedef float f32x2 __attribute__((ext_vector_type(2)));
typedef unsigned u32x4 __attribute__((ext_vector_type(4)));
typedef unsigned u32x2 __attribute__((ext_vector_type(2)));
typedef GAS unsigned gu32;
typedef int v8i __attribute__((ext_vector_type(8)));
typedef int v4i __attribute__((ext_vector_type(4)));

constexpr int DM = 4096, NB = 4, SEQ = 4096, MTOK = NB * SEQ, DFF = 11008, DSSM = 2048, DCONV = 2048, NMEM = 256, MMEM = NB * NMEM, NH = 4, HD = 1024;
constexpr int NG = 128, GH = 16, GP = 64, MIXC = 16384;
constexpr float RMS_EPS = 1e-6f;
constexpr int NWAVES = 8;

constexpr size_t MiB = 1u << 20;
constexpr size_t WS_CTL = 0, CTL_ZERO_BYTES = 1 * MiB;
constexpr size_t WS_STATS = 1 * MiB;
constexpr size_t WS_W1IN = 5 * MiB;
constexpr size_t WS_W1OUT = WS_W1IN + 172 * MiB;
constexpr size_t WS_WMIX = WS_W1OUT + 86 * MiB;
constexpr size_t WS_WGLU = WS_WMIX + 128 * MiB;
constexpr size_t WS_WCOUT = WS_WGLU + 32 * MiB;
constexpr size_t WS_WMO = WS_WCOUT + 16 * MiB;
constexpr size_t WS_WQ = WS_WMO + 32 * MiB;
constexpr size_t WS_WK = WS_WQ + 32 * MiB;
constexpr size_t WS_WV = WS_WK + 32 * MiB;
constexpr size_t WS_WO = WS_WV + 32 * MiB;
constexpr size_t WS_W2IN = WS_WO + 32 * MiB;
constexpr size_t WS_W2OUT = WS_W2IN + 172 * MiB;
constexpr size_t WS_XB = WS_W2OUT + 86 * MiB;
constexpr size_t WS_BIG = WS_XB + 128 * MiB;
constexpr size_t WS_YS = WS_BIG + 448 * MiB;
constexpr size_t WS_YCV = WS_YS + 64 * MiB;
constexpr size_t WS_MEMN = WS_YCV + 64 * MiB;
constexpr size_t WS_KV = WS_MEMN + 8 * MiB;
constexpr size_t WS_SSMC = WS_KV + 16 * MiB;
constexpr size_t WS_WQK = WS_SSMC + 2 * MiB;
constexpr size_t WS_WVO = WS_WQK + 32 * MiB;
constexpr size_t WS_ESEG = WS_WVO + 32 * MiB;
constexpr size_t WS_XB8 = WS_ESEG + 1 * MiB;
constexpr size_t WS_END = WS_XB8 + 64 * MiB;
constexpr size_t WS_WMIX8 = WS_WMIX + (size_t)8192 * DM * 2;
constexpr size_t BG_HID = 0;
constexpr size_t BG_USSM = 0, BG_CB = 64 * MiB, BG_ZC = 128 * MiB, BG_GA = 192 * MiB, BG_GB = 320 * MiB;
constexpr size_t BG_TMP = 0;
constexpr size_t BG_P = 128 * MiB;

constexpr int CW_BAR = 4096;
constexpr int CW_COLMAX = 8192;
constexpr size_t WS_ROWFAC = WS_SSMC + 1664 * 1024;
constexpr size_t WS_COLSC1 = WS_SSMC + 1728 * 1024;
constexpr size_t WS_COLSC2 = WS_SSMC + 1816 * 1024;
constexpr size_t WS_COLSC4 = WS_SSMC + 1968 * 1024;
constexpr size_t WS_ROWFACM = WS_SSMC + 2000 * 1024;
constexpr size_t WS_COLSC3 = WS_SSMC + 1904 * 1024;

constexpr int RING_BYTES = 131072;
constexpr int XCH_OFF = 131072;
constexpr int RSTD_OFF = 143360;
constexpr int MISC_OFF = 144384;
constexpr int LDS_BYTES = 147456;

#define LDS_WAIT() asm volatile("s_waitcnt lgkmcnt(0)" ::: "memory")
#define VM_WAIT() asm volatile("s_waitcnt vmcnt(0)" ::: "memory")

__device__ __forceinline__ unsigned f2bf(float f) { unsigned u = __builtin_bit_cast(unsigned, f); return (u + 0x7fffu + ((u >> 16) & 1u)) >> 16; }
__device__ __forceinline__ unsigned pk2(float lo, float hi) { return f2bf(lo) | (f2bf(hi) << 16); }
typedef __bf16 bf16x2_t __attribute__((ext_vector_type(2)));
__device__ __forceinline__ unsigned cvt_pk_bf16(float lo, float hi) { const f32x2 v = {lo, hi}; const bf16x2_t b = __builtin_convertvector(v, bf16x2_t); return __builtin_bit_cast(unsigned, b); }
__device__ __forceinline__ float bf_lo(unsigned w) { return __builtin_bit_cast(float, w << 16); }
__device__ __forceinline__ float bf_hi(unsigned w) { return __builtin_bit_cast(float, w & 0xffff0000u); }
__device__ __forceinline__ float sigmoidf_(float x) { return __builtin_amdgcn_rcpf(1.0f + __builtin_amdgcn_exp2f(-1.4426950408889634f * x)); }
__device__ __forceinline__ float wave_sum(float v) {
#pragma unroll
    for (int o = 1; o < 64; o <<= 1) v += __shfl_xor(v, o);
    return v;
}
__device__ __forceinline__ float wave_max(float v) {
#pragma unroll
    for (int o = 1; o < 64; o <<= 1) v = fmaxf(v, __shfl_xor(v, o));
    return v;
}
__device__ __forceinline__ float gelu1(float v) {
    const float av = fabsf(v), d = av * 0.2316418882f + 1.0f;
    const float t = __builtin_amdgcn_rcpf(d);
    float q = t * 0.5307027145f + (-0.7265760135f); q = q * t + 0.7107068705f; q = q * t + (-0.142248368f); q = q * t + 0.127414796f; q = q * t;
    const float e = __builtin_amdgcn_exp2f((v * v) * (-0.72134752044f));
    const float m = v * (q * e), r = v - m;
    return v < 0.f ? m : r;
}

namespace pg8 {
constexpr int BM = 256, BK = 64, HALF = 128, HTB = HALF * BK * 2, STAGE_BYTES = 8 * HTB, NXCD = 8, WGM = 8;
__host__ __device__ __forceinline__ int lds_byte(int r, int c) { const int st = (r >> 4) * 2 + (c >> 5), rr = r & 15, cc = c & 31, ob = rr * 64 + cc * 2; return st * 1024 + (ob ^ (((ob >> 9) & 1) << 5)); }
__host__ __device__ __forceinline__ void stage_rc(int b, int& R, int& C) { const int st = b / 1024, sb = b % 1024, swz = sb ^ (((sb >> 9) & 1) << 5); R = (st >> 1) * 16 + swz / 64; C = (st & 1) * 32 + (swz % 64) / 2; }
__host__ __device__ __forceinline__ int perm32(int rho) { const int n = rho >> 4, i = rho & 15; return 8 * (i >> 2) + 4 * n + (i & 3); }

struct Unit { int pm, pn; };
struct StaticOrder {
    int nM, nN, nwg, G, c;
    __host__ __device__ __forceinline__ void init(int M, int N, int G_, int c_) { nM = M / BM; nN = N / BM; nwg = nM * nN; G = G_; c = c_; }
    __host__ __device__ __forceinline__ bool next(int i, Unit& u) const {
        const long L = (long)i * G + c; if (L >= nwg) return false;
        int wgid = (int)L; { const int q = nwg / NXCD, r = nwg % NXCD, xcd = wgid % NXCD, off = wgid / NXCD; wgid = (xcd < r ? xcd * (q + 1) : r * (q + 1) + (xcd - r) * q) + off; }
        const int nig = WGM * nN, gid = wgid / nig, fm = gid * WGM, gsz = (nM - fm) < WGM ? (nM - fm) : WGM;
        u.pm = fm + ((wgid % nig) % gsz); u.pn = (wgid % nig) / gsz; return true;
    }
};
struct PanelOrder {
    int nM, G, c;
    __host__ __device__ __forceinline__ void init(int M, int N, int G_, int c_) { nM = M / BM; G = G_; c = c_; (void)N; }
    __host__ __device__ __forceinline__ bool next(int i, Unit& u) const {
        if (16 * i >= nM) return false;
        const int x = c & 7, j = c >> 3;
        u.pm = 16 * i + 8 * (x & 1) + (j & 7); u.pn = 4 * (x >> 1) + (j >> 3); return true;
    }
};
struct AddrStd { const char* A; const char* B; unsigned ta, tb;
    __device__ __forceinline__ const char* abase() const { return A; } __device__ __forceinline__ const char* bbase() const { return B; }
    __device__ __forceinline__ unsigned a(const Unit& u) const { return (unsigned)u.pm * ta; }
    __device__ __forceinline__ unsigned b(const Unit& u) const { return (unsigned)u.pn * tb; } };
struct AddrMixI8 { const char* A; const char* B; unsigned ta, tb;
    __device__ __forceinline__ const char* abase() const { return A; } __device__ __forceinline__ const char* bbase() const { return B; }
    __device__ __forceinline__ unsigned a(const Unit& u) const { return (unsigned)u.pm * ta; }
    __device__ __forceinline__ unsigned b(const Unit& u) const { return (unsigned)(u.pn + (u.pn >= 16 ? 16 : 0)) * tb; } };
struct AddrQK {
    const char* KV; const char* WqN;
    __device__ __forceinline__ const char* abase() const { return KV; } __device__ __forceinline__ const char* bbase() const { return WqN; }
    __device__ __forceinline__ unsigned a(const Unit& u) const { return ((unsigned)(u.pm >> 2) * NMEM * (2 * DM) + (unsigned)(u.pm & 3) * HD) * 2u; }
    __device__ __forceinline__ unsigned b(const Unit& u) const { return ((unsigned)u.pn * 256 * DM + (unsigned)(u.pm & 3) * HD) * 2u; } };
struct AddrVO {
    const char* WoT; const char* KV;
    __device__ __forceinline__ const char* abase() const { return WoT; } __device__ __forceinline__ const char* bbase() const { return KV; }
    __device__ __forceinline__ unsigned a(const Unit& u) const { return ((unsigned)u.pm * 256 * DM + (unsigned)(u.pn & 3) * HD) * 2u; }
    __device__ __forceinline__ unsigned b(const Unit& u) const { return ((unsigned)(u.pn >> 2) * NMEM * (2 * DM) + DM + (unsigned)(u.pn & 3) * HD) * 2u; } };
struct AddrSc {
    const char* X; const char* Wqk;
    __device__ __forceinline__ const char* abase() const { return X; } __device__ __forceinline__ const char* bbase() const { return Wqk; }
    __device__ __forceinline__ unsigned a(const Unit& u) const { return (unsigned)u.pm * 256 * DM * 2u; }
    __device__ __forceinline__ unsigned b(const Unit& u) const { return ((unsigned)(u.pm >> 4) * 1024 + (unsigned)u.pn * 256) * DM * 2u; } };
struct AddrAO {
    const char* P; const char* Wvo;
    __device__ __forceinline__ const char* abase() const { return P; } __device__ __forceinline__ const char* bbase() const { return Wvo; }
    __device__ __forceinline__ unsigned a(const Unit& u) const { return (unsigned)u.pm * 256 * 1024 * 2u; }
    __device__ __forceinline__ unsigned b(const Unit& u) const { return ((unsigned)u.pn * 256 * DM + (unsigned)(u.pm >> 4) * 1024) * 2u; } };

struct AddrSc8 {
    const char* X; const char* Wqk;
    __device__ __forceinline__ const char* abase() const { return X; } __device__ __forceinline__ const char* bbase() const { return Wqk; }
    __device__ __forceinline__ unsigned a(const Unit& u) const { return (unsigned)u.pm * 256 * DM; }
    __device__ __forceinline__ unsigned b(const Unit& u) const { return ((unsigned)(u.pm >> 4) * 1024 + (unsigned)u.pn * 256) * DM; } };
struct AddrAO8 {
    const char* P; const char* Wvo;
    __device__ __forceinline__ const char* abase() const { return P; } __device__ __forceinline__ const char* bbase() const { return Wvo; }
    __device__ __forceinline__ unsigned a(const Unit& u) const { return (unsigned)u.pm * 256 * 1024; }
    __device__ __forceinline__ unsigned b(const Unit& u) const { return (unsigned)u.pn * 256 * DM + (unsigned)(u.pm >> 4) * 1024; } };
typedef f32x4 Acc[2][2][4][2];

template <int MODE = 0  , class Epi, class Sched, class Addr>
__device__ __forceinline__ void gemm_phase(LAS unsigned char* lds, const int K, const int lda, const int ldb, const Addr& AD, const Sched& S, const Epi& E) {
    const int tid = threadIdx.x, wid = __builtin_amdgcn_readfirstlane(tid >> 6), lane = tid & 63, wr = wid >> 2, wc = wid & 3, fr = lane & 15, fq = lane >> 4;
    int nt = K / BK; asm volatile("" : "+s"(nt));
    unsigned voffA, voffB;
    { int R, C; stage_rc(tid * 16, R, C); const int Rb = (R & ~31) + perm32(R & 31); voffA = (unsigned)(R * lda + C) * 2u; voffB = (unsigned)(Rb * ldb + C) * 2u; }
    const unsigned pstepA = 64u * (unsigned)lda * 2u, pstepB = 64u * (unsigned)ldb * 2u;
    const unsigned kstep = (unsigned)(BK * 2);
    const unsigned hstepA = (unsigned)HALF * lda * 2u, hstepB = (unsigned)HALF * ldb * 2u;
    const __amdgpu_buffer_rsrc_t rA = __builtin_amdgcn_make_buffer_rsrc((void*)AD.abase(), 0, (int)0xffffffffu, 0x00020000);
    const __amdgpu_buffer_rsrc_t rB = __builtin_amdgcn_make_buffer_rsrc((void*)AD.bbase(), 0, (int)0xffffffffu, 0x00020000);
    const unsigned ldsw = (unsigned)wid * 1024u;
    const int aoff = lds_byte(wr * 64 + fr, fq * 8), boff = lds_byte(wc * 32 + fr, fq * 8);
#define PG8_SA(b, h) (((b) * 2 + (h)) * HTB)
#define PG8_SB(b, h) ((4 + (b) * 2 + (h)) * HTB)
#define PG8_STAGE(bufoff, rs, soff, voff) do { _Pragma("unroll") for (int _i = 0; _i < 2; ++_i) \
        __builtin_amdgcn_raw_ptr_buffer_load_lds(rs, (LAS void*)(lds + (bufoff) + ldsw + _i * 8192), 16, (voff), (soff) + _i * p##voff, 0, 0); } while (0)
#define pvoffA pstepA
#define pvoffB pstepB
#define PG8_LDA(dst, b, h) do { _Pragma("unroll") for (int m = 0; m < 4; ++m) { const v4i _l = *(const LAS v4i*)(lds + PG8_SA(b, h) + aoff + m * 2048), _h = *(const LAS v4i*)(lds + PG8_SA(b, h) + aoff + m * 2048 + 1024); \
        dst[m] = __builtin_shufflevector(_l, _h, 0, 1, 2, 3, 4, 5, 6, 7); } } while (0)
#define PG8_LDB(dst, b, h) do { _Pragma("unroll") for (int n = 0; n < 2; ++n) { const v4i _l = *(const LAS v4i*)(lds + PG8_SB(b, h) + boff + n * 2048), _h = *(const LAS v4i*)(lds + PG8_SB(b, h) + boff + n * 2048 + 1024); \
        dst[n] = __builtin_shufflevector(_l, _h, 0, 1, 2, 3, 4, 5, 6, 7); } } while (0)
#define PG8_LO(v) __builtin_bit_cast(bf16x8, __builtin_shufflevector(v, v, 0, 1, 2, 3))
#define PG8_HI(v) __builtin_bit_cast(bf16x8, __builtin_shufflevector(v, v, 4, 5, 6, 7))
#define PG8_LO4(v) __builtin_shufflevector(v, v, 0, 1, 2, 3)
#define PG8_HI4(v) __builtin_shufflevector(v, v, 4, 5, 6, 7)
#define PG8_MMA(ai, bj, At, Bt) do { __builtin_amdgcn_s_setprio(1); _Pragma("unroll") for (int m = 0; m < 4; ++m) _Pragma("unroll") for (int n = 0; n < 2; ++n) { \
        if constexpr (MODE == 1) acc[ai][bj][m][n] = __builtin_amdgcn_mfma_scale_f32_16x16x128_f8f6f4(Bt[n], At[m], acc[ai][bj][m][n], 0, 0, 0, 0, 0, 0); \
        else if constexpr (MODE == 2) { v4i _c = __builtin_bit_cast(v4i, acc[ai][bj][m][n]); \
               _c = __builtin_amdgcn_mfma_i32_16x16x64_i8(PG8_LO4(Bt[n]), PG8_LO4(At[m]), _c, 0, 0, 0); _c = __builtin_amdgcn_mfma_i32_16x16x64_i8(PG8_HI4(Bt[n]), PG8_HI4(At[m]), _c, 0, 0, 0); \
               acc[ai][bj][m][n] = __builtin_bit_cast(f32x4, _c); } \
        else { acc[ai][bj][m][n] = __builtin_amdgcn_mfma_f32_16x16x32_bf16(PG8_LO(Bt[n]), PG8_LO(At[m]), acc[ai][bj][m][n], 0, 0, 0); \
               acc[ai][bj][m][n] = __builtin_amdgcn_mfma_f32_16x16x32_bf16(PG8_HI(Bt[n]), PG8_HI(At[m]), acc[ai][bj][m][n], 0, 0, 0); } } \
        __builtin_amdgcn_s_setprio(0); } while (0)
#define PG8_WAIT_V(n) asm volatile("s_waitcnt vmcnt(" #n ")" ::: "memory")
#define PG8_WAIT_L(n) asm volatile("s_waitcnt lgkmcnt(" #n ")" ::: "memory")
#define PG8_BAR __builtin_amdgcn_s_barrier()
#define PG8_SCHED __builtin_amdgcn_sched_barrier(0)
    Unit cur, nxt; int ui = 0;
    if (!S.next(0, cur)) return;
    Acc acc;
#pragma unroll
    for (int a = 0; a < 2; ++a)
#pragma unroll
        for (int b = 0; b < 2; ++b)
#pragma unroll
            for (int m = 0; m < 4; ++m)
#pragma unroll
                for (int n = 0; n < 2; ++n) acc[a][b][m][n] = (f32x4){0.f, 0.f, 0.f, 0.f};
    v8i At[4], B0[2], B1[2];
    unsigned cA = AD.a(cur), cB = AD.b(cur);
    PG8_STAGE(PG8_SB(0, 0), rB, cB, voffB); PG8_STAGE(PG8_SB(0, 1), rB, cB + hstepB, voffB); PG8_STAGE(PG8_SA(0, 0), rA, cA, voffA); PG8_STAGE(PG8_SA(0, 1), rA, cA + hstepA, voffA);
    if (wr == 1) PG8_BAR;
    PG8_WAIT_V(2); PG8_BAR;
    PG8_STAGE(PG8_SB(1, 0), rB, cB + kstep, voffB); PG8_STAGE(PG8_SA(1, 0), rA, cA + kstep, voffA); PG8_STAGE(PG8_SB(1, 1), rB, cB + hstepB + kstep, voffB);
    PG8_WAIT_V(6); PG8_BAR;
    for (;;) {
        const bool has_next = S.next(ui + 1, nxt);
        const unsigned nA = has_next ? AD.a(nxt) : cA, nB = has_next ? AD.b(nxt) : cB;
        for (int t = 0; t < nt; t += 2) {
            const bool last = (t == nt - 2);
            const unsigned a1 = cA + (unsigned)(t + 1) * kstep;
            const unsigned a2 = last ? nA : cA + (unsigned)(t + 2) * kstep, b2 = last ? nB : cB + (unsigned)(t + 2) * kstep;
            const unsigned a3 = a2 + kstep, b3 = b2 + kstep;
            PG8_LDB(B0, 0, 0); PG8_LDB(B1, 0, 1); PG8_SCHED; PG8_LDA(At, 0, 0); PG8_STAGE(PG8_SA(1, 1), rA, a1 + hstepA, voffA);
            PG8_WAIT_V(8); PG8_WAIT_L(0); PG8_BAR; PG8_MMA(0, 0, At, B0); PG8_MMA(0, 1, At, B1); PG8_BAR; PG8_SCHED;
            PG8_LDA(At, 0, 1); PG8_STAGE(PG8_SB(0, 0), rB, b2, voffB); PG8_STAGE(PG8_SB(0, 1), rB, b2 + hstepB, voffB); PG8_STAGE(PG8_SA(0, 0), rA, a2, voffA);
            PG8_WAIT_V(8); PG8_WAIT_L(0); PG8_BAR; PG8_MMA(1, 0, At, B0); PG8_MMA(1, 1, At, B1); PG8_BAR; PG8_SCHED;
            PG8_LDB(B0, 1, 0); PG8_LDB(B1, 1, 1); PG8_SCHED; PG8_LDA(At, 1, 0); PG8_STAGE(PG8_SA(0, 1), rA, a2 + hstepA, voffA);
            PG8_WAIT_V(8); PG8_WAIT_L(0); PG8_BAR; PG8_MMA(0, 0, At, B0); PG8_MMA(0, 1, At, B1); PG8_BAR; PG8_SCHED;
            PG8_LDA(At, 1, 1); PG8_STAGE(PG8_SB(1, 0), rB, b3, voffB); PG8_STAGE(PG8_SB(1, 1), rB, b3 + hstepB, voffB); PG8_STAGE(PG8_SA(1, 0), rA, a3, voffA);
            PG8_WAIT_V(8); PG8_WAIT_L(0); PG8_BAR; PG8_MMA(1, 0, At, B0); PG8_MMA(1, 1, At, B1); PG8_BAR; PG8_SCHED;
        }
        if (wr == 0) PG8_BAR;
        { int tz = threadIdx.x; asm volatile("" : "+v"(tz));
          const int wid2 = __builtin_amdgcn_readfirstlane(tz >> 6), lane2 = tz & 63;
          E(acc, cur, wid2 >> 2, wid2 & 3, lane2 & 15, lane2 >> 4); }
        if (!has_next) break;
#pragma unroll
        for (int a = 0; a < 2; ++a)
#pragma unroll
            for (int b = 0; b < 2; ++b)
#pragma unroll
                for (int m = 0; m < 4; ++m)
#pragma unroll
                    for (int n = 0; n < 2; ++n) acc[a][b][m][n] = (f32x4){0.f, 0.f, 0.f, 0.f};
        cur = nxt; cA = nA; cB = nB; ++ui;
        if (wr == 1) PG8_BAR;
    }
    PG8_WAIT_V(0);
    PG8_BAR;
#undef PG8_SA
#undef PG8_SB
#undef PG8_STAGE
#undef pvoffA
#undef pvoffB
#undef PG8_LDA
#undef PG8_LDB
#undef PG8_MMA
#undef PG8_LO4
#undef PG8_HI4
#undef PG8_LO
#undef PG8_HI
#undef PG8_WAIT_V
#undef PG8_WAIT_L
#undef PG8_BAR
#undef PG8_SCHED
}

struct EpiBf16 {
    bf16* O; int ldc; const LAS float* rstd; float scale;
    __device__ __forceinline__ void operator()(const Acc& acc, const Unit& u, int wr, int wc, int fr, int fq) const {
        const int col0 = u.pn * BM + wc * 32 + 8 * fq;
#pragma unroll
        for (int ai = 0; ai < 2; ++ai)
#pragma unroll
            for (int m = 0; m < 4; ++m) { const int rl = ai * HALF + wr * 64 + m * 16 + fr; const float s = (rstd ? rstd[rl] : 1.0f) * scale;
                bf16* rowp = O + (size_t)(u.pm * BM + rl) * ldc + col0;
#pragma unroll
                for (int bj = 0; bj < 2; ++bj) { const f32x4 v0 = acc[ai][bj][m][0] * s, v1 = acc[ai][bj][m][1] * s;
                    u32x4 w; w.x = cvt_pk_bf16(v0[0], v0[1]); w.y = cvt_pk_bf16(v0[2], v0[3]); w.z = cvt_pk_bf16(v1[0], v1[1]); w.w = cvt_pk_bf16(v1[2], v1[3]);
                    *(u32x4*)(rowp + bj * HALF) = w; } }
    }
};
struct EpiBf16I8 {
    bf16* O; int ldc; const float* rowfac; const float* colsc;
    __device__ __forceinline__ void operator()(const Acc& acc, const Unit& u, int wr, int wc, int fr, int fq) const {
        const int col0 = u.pn * BM + wc * 32 + 8 * fq;
        f32x4 cs[2][2];
#pragma unroll
        for (int bj = 0; bj < 2; ++bj)
#pragma unroll
            for (int n = 0; n < 2; ++n) cs[bj][n] = *(const GAS f32x4*)(colsc + col0 + bj * HALF + 4 * n);
#pragma unroll
        for (int ai = 0; ai < 2; ++ai)
#pragma unroll
            for (int m = 0; m < 4; ++m) { const int r = u.pm * BM + ai * HALF + wr * 64 + m * 16 + fr; const float rf = ((const GAS float*)rowfac)[r];
                bf16* rowp = O + (size_t)r * ldc + col0;
#pragma unroll
                for (int bj = 0; bj < 2; ++bj) { const v4i i0 = __builtin_bit_cast(v4i, acc[ai][bj][m][0]), i1 = __builtin_bit_cast(v4i, acc[ai][bj][m][1]); f32x4 v0, v1;
#pragma unroll
                    for (int j = 0; j < 4; ++j) { v0[j] = (float)i0[j] * (rf * cs[bj][0][j]); v1[j] = (float)i1[j] * (rf * cs[bj][1][j]); }
                    u32x4 w; w.x = cvt_pk_bf16(v0[0], v0[1]); w.y = cvt_pk_bf16(v0[2], v0[3]); w.z = cvt_pk_bf16(v1[0], v1[1]); w.w = cvt_pk_bf16(v1[2], v1[3]);
                    *(u32x4*)(rowp + bj * HALF) = w; } }
    }
};
struct EpiFp8 {
    unsigned char* O; int ldc; float scale;
    __device__ __forceinline__ void operator()(const Acc& acc, const Unit& u, int wr, int wc, int fr, int fq) const {
        const int col0 = u.pn * BM + wc * 32 + 8 * fq;
#pragma unroll
        for (int ai = 0; ai < 2; ++ai)
#pragma unroll
            for (int m = 0; m < 4; ++m) { unsigned char* rowp = O + (size_t)(u.pm * BM + ai * HALF + wr * 64 + m * 16 + fr) * ldc + col0;
#pragma unroll
                for (int bj = 0; bj < 2; ++bj) { const f32x4 v0 = acc[ai][bj][m][0] * scale, v1 = acc[ai][bj][m][1] * scale; unsigned w0 = 0u, w1 = 0u;
                    w0 = __builtin_amdgcn_cvt_pk_fp8_f32(v0[0], v0[1], w0, false); w0 = __builtin_amdgcn_cvt_pk_fp8_f32(v0[2], v0[3], w0, true);
                    w1 = __builtin_amdgcn_cvt_pk_fp8_f32(v1[0], v1[1], w1, false); w1 = __builtin_amdgcn_cvt_pk_fp8_f32(v1[2], v1[3], w1, true);
                    u32x2 w; w.x = w0; w.y = w1; *(u32x2*)(rowp + bj * HALF) = w; } }
    }
};
template <bool P8> struct EpiSoftmax {
    bf16* P; const LAS float* rstd; LAS float* xch; float scale2;
    __device__ __forceinline__ void operator()(Acc& acc, const Unit& u, int wr, int wc, int fr, int fq) const {
        LAS float* xmax = xch; LAS float* xsum = xch + 1024;
#pragma unroll
        for (int ai = 0; ai < 2; ++ai)
#pragma unroll
            for (int m = 0; m < 4; ++m) { const int rl = ai * HALF + wr * 64 + m * 16 + fr; const float s = rstd[rl] * scale2; float mx = -3.0e38f;
#pragma unroll
                for (int bj = 0; bj < 2; ++bj)
#pragma unroll
                    for (int n = 0; n < 2; ++n) { f32x4 t = acc[ai][bj][m][n] * s; acc[ai][bj][m][n] = t; mx = fmaxf(mx, fmaxf(fmaxf(t[0], t[1]), fmaxf(t[2], t[3]))); }
                mx = fmaxf(mx, __shfl_xor(mx, 16)); mx = fmaxf(mx, __shfl_xor(mx, 32));
                if (fq == 0) xmax[rl * 4 + wc] = mx; }
        LDS_WAIT(); __builtin_amdgcn_s_barrier(); asm volatile("" ::: "memory");
#pragma unroll
        for (int ai = 0; ai < 2; ++ai)
#pragma unroll
            for (int m = 0; m < 4; ++m) { const int rl = ai * HALF + wr * 64 + m * 16 + fr; const f32x4 pm4 = *(const LAS f32x4*)(xmax + rl * 4);
                const float M = fmaxf(fmaxf(pm4[0], pm4[1]), fmaxf(pm4[2], pm4[3])); float sm = 0.f;
#pragma unroll
                for (int bj = 0; bj < 2; ++bj)
#pragma unroll
                    for (int n = 0; n < 2; ++n) { f32x4 t = acc[ai][bj][m][n];
#pragma unroll
                        for (int j = 0; j < 4; ++j) { t[j] = __builtin_amdgcn_exp2f(t[j] - M); sm += t[j]; }
                        acc[ai][bj][m][n] = t; }
                sm += __shfl_xor(sm, 16); sm += __shfl_xor(sm, 32);
                if (fq == 0) xsum[rl * 4 + wc] = sm; }
        LDS_WAIT(); __builtin_amdgcn_s_barrier(); asm volatile("" ::: "memory");
        const int col0 = u.pn * BM + wc * 32 + 8 * fq;
#pragma unroll
        for (int ai = 0; ai < 2; ++ai)
#pragma unroll
            for (int m = 0; m < 4; ++m) { const int rl = ai * HALF + wr * 64 + m * 16 + fr; const f32x4 s4 = *(const LAS f32x4*)(xsum + rl * 4);
                const float inv = (P8 ? 256.0f : 1.0f) / ((s4[0] + s4[1]) + (s4[2] + s4[3]));
                if constexpr (P8) { unsigned char* rowp = (unsigned char*)P + (size_t)(u.pm * BM + rl) * (NH * NMEM) + col0;
#pragma unroll
                    for (int bj = 0; bj < 2; ++bj) { const f32x4 v0 = acc[ai][bj][m][0] * inv, v1 = acc[ai][bj][m][1] * inv; unsigned w0 = 0u, w1 = 0u;
                        w0 = __builtin_amdgcn_cvt_pk_fp8_f32(v0[0], v0[1], w0, false); w0 = __builtin_amdgcn_cvt_pk_fp8_f32(v0[2], v0[3], w0, true);
                        w1 = __builtin_amdgcn_cvt_pk_fp8_f32(v1[0], v1[1], w1, false); w1 = __builtin_amdgcn_cvt_pk_fp8_f32(v1[2], v1[3], w1, true);
                        u32x2 w; w.x = w0; w.y = w1; *(u32x2*)(rowp + bj * HALF) = w; } }
                else { bf16* rowp = P + (size_t)(u.pm * BM + rl) * (NH * NMEM) + col0;
#pragma unroll
                    for (int bj = 0; bj < 2; ++bj) { const f32x4 v0 = acc[ai][bj][m][0] * inv, v1 = acc[ai][bj][m][1] * inv;
                        u32x4 w; w.x = cvt_pk_bf16(v0[0], v0[1]); w.y = cvt_pk_bf16(v0[2], v0[3]); w.z = cvt_pk_bf16(v1[0], v1[1]); w.w = cvt_pk_bf16(v1[2], v1[3]);
                        *(u32x4*)(rowp + bj * HALF) = w; } } }
    }
};
struct EpiSwiglu {
    bf16* O; int ldc; const LAS float* rstd;
    __device__ __forceinline__ void operator()(const Acc& acc, const Unit& u, int wr, int wc, int fr, int fq) const {
        const int col0 = u.pn * HALF + wc * 32 + 8 * fq;
#pragma unroll
        for (int ai = 0; ai < 2; ++ai)
#pragma unroll
            for (int m = 0; m < 4; ++m) { const int rl = ai * HALF + wr * 64 + m * 16 + fr; const float s = rstd[rl];
                float o[8];
#pragma unroll
                for (int n = 0; n < 2; ++n)
#pragma unroll
                    for (int j = 0; j < 4; ++j) { const float a = acc[ai][0][m][n][j] * s, b = acc[ai][1][m][n][j] * s; o[n * 4 + j] = a * sigmoidf_(a) * b; }
                u32x4 w; w.x = cvt_pk_bf16(o[0], o[1]); w.y = cvt_pk_bf16(o[2], o[3]); w.z = cvt_pk_bf16(o[4], o[5]); w.w = cvt_pk_bf16(o[6], o[7]);
                *(u32x4*)(O + (size_t)(u.pm * BM + rl) * ldc + col0) = w; }
    }
};
struct EpiSwigluI8 {
    bf16* O; int ldc; const LAS float* rowfac; const float* colsc;
    __device__ __forceinline__ void operator()(const Acc& acc, const Unit& u, int wr, int wc, int fr, int fq) const {
        const int col0 = u.pn * HALF + wc * 32 + 8 * fq, nt0 = u.pn * BM + wc * 32 + 8 * fq;
        f32x4 ca[2], cb[2];
#pragma unroll
        for (int n = 0; n < 2; ++n) { ca[n] = *(const GAS f32x4*)(colsc + nt0 + 4 * n); cb[n] = *(const GAS f32x4*)(colsc + nt0 + HALF + 4 * n); }
#pragma unroll
        for (int ai = 0; ai < 2; ++ai)
#pragma unroll
            for (int m = 0; m < 4; ++m) { const int rl = ai * HALF + wr * 64 + m * 16 + fr; const float rf = rowfac[rl]; float o[8];
#pragma unroll
                for (int n = 0; n < 2; ++n) { const v4i ia = __builtin_bit_cast(v4i, acc[ai][0][m][n]), ib = __builtin_bit_cast(v4i, acc[ai][1][m][n]);
#pragma unroll
                    for (int j = 0; j < 4; ++j) { const float a = (float)ia[j] * (rf * ca[n][j]), b = (float)ib[j] * (rf * cb[n][j]); o[n * 4 + j] = a * sigmoidf_(a) * b; } }
                u32x4 w; w.x = cvt_pk_bf16(o[0], o[1]); w.y = cvt_pk_bf16(o[2], o[3]); w.z = cvt_pk_bf16(o[4], o[5]); w.w = cvt_pk_bf16(o[6], o[7]);
                *(u32x4*)(O + (size_t)(u.pm * BM + rl) * ldc + col0) = w; }
    }
};
template <bool WB, bool ST, bool HALFSC, bool W8 = false, bool WF = false, bool S8 = false, bool XF = false> struct EpiRes {
    static constexpr float scale = (HALFSC ? 0.5f : 1.0f) * (S8 ? 0.00390625f : 1.0f);
    float* out; bf16* xb; float* stats; unsigned char* xb8; const float* xf;
    __device__ __forceinline__ void operator()(const Acc& acc, const Unit& u, int wr, int wc, int fr, int fq) const {
        const int col0 = u.pn * BM + wc * 32 + 8 * fq;
#pragma unroll
        for (int ai = 0; ai < 2; ++ai)
#pragma unroll
            for (int m = 0; m < 4; ++m) { const int r = u.pm * BM + ai * HALF + wr * 64 + m * 16 + fr; const size_t off = (size_t)r * DM + col0; float ss = 0.f;
#pragma unroll
                for (int bj = 0; bj < 2; ++bj) { f32x4 h0, h1;
                    if constexpr (XF) { h0 = *(const f32x4*)(xf + off + bj * HALF); h1 = *(const f32x4*)(xf + off + bj * HALF + 4); }
                    else { const u32x4 g = *(const u32x4*)(xb + off + bj * HALF);
                        h0 = (f32x4){bf_lo(g.x), bf_hi(g.x), bf_lo(g.y), bf_hi(g.y)}; h1 = (f32x4){bf_lo(g.z), bf_hi(g.z), bf_lo(g.w), bf_hi(g.w)}; }
                    const f32x4 v0 = h0 + acc[ai][bj][m][0] * scale, v1 = h1 + acc[ai][bj][m][1] * scale;
                    if (WF) { *(f32x4*)(out + off + bj * HALF) = v0; *(f32x4*)(out + off + bj * HALF + 4) = v1; }
                    if (WB) { u32x4 w; w.x = cvt_pk_bf16(v0[0], v0[1]); w.y = cvt_pk_bf16(v0[2], v0[3]); w.z = cvt_pk_bf16(v1[0], v1[1]); w.w = cvt_pk_bf16(v1[2], v1[3]);
                        *(u32x4*)(xb + off + bj * HALF) = w; }
                    if (W8) { unsigned w0 = 0u, w1 = 0u; w0 = __builtin_amdgcn_cvt_pk_fp8_f32(v0[0], v0[1], w0, false); w0 = __builtin_amdgcn_cvt_pk_fp8_f32(v0[2], v0[3], w0, true);
                        w1 = __builtin_amdgcn_cvt_pk_fp8_f32(v1[0], v1[1], w1, false); w1 = __builtin_amdgcn_cvt_pk_fp8_f32(v1[2], v1[3], w1, true);
                        u32x2 w8; w8.x = w0; w8.y = w1; *(u32x2*)(xb8 + off + bj * HALF) = w8; }
                    if (ST) ss += (v0[0] * v0[0] + v0[1] * v0[1]) + (v0[2] * v0[2] + v0[3] * v0[3]) + (v1[0] * v1[0] + v1[1] * v1[1]) + (v1[2] * v1[2] + v1[3] * v1[3]); }
                if (ST) { ss += __shfl_xor(ss, 16); ss += __shfl_xor(ss, 32); if (fq == 0) stats[(size_t)r * 64 + u.pn * 4 + wc] = ss; }
                asm volatile("" ::: "memory"); }
    }
};
struct EpiMix {
    bf16* ussm; bf16* cb; bf16* zc; bf16* ga; bf16* gb; const LAS float* rstd;
    __device__ __forceinline__ void operator()(const Acc& acc, const Unit& u, int wr, int wc, int fr, int fq) const {
        const int pn = u.pn;
        if (pn >= 16 && pn < 32) {
            const int col0 = (pn - 16) * HALF + wc * 32 + 8 * fq;
#pragma unroll
            for (int ai = 0; ai < 2; ++ai)
#pragma unroll
                for (int m = 0; m < 4; ++m) { const int rl = ai * HALF + wr * 64 + m * 16 + fr; const float s = rstd[rl]; float o[8];
#pragma unroll
                    for (int n = 0; n < 2; ++n)
#pragma unroll
                        for (int j = 0; j < 4; ++j) o[n * 4 + j] = (acc[ai][0][m][n][j] * s) * (acc[ai][1][m][n][j] * s);
                    u32x4 w; w.x = cvt_pk_bf16(o[0], o[1]); w.y = cvt_pk_bf16(o[2], o[3]); w.z = cvt_pk_bf16(o[4], o[5]); w.w = cvt_pk_bf16(o[6], o[7]);
                    *(u32x4*)(zc + (size_t)(u.pm * BM + rl) * DCONV + col0) = w; }
        } else {
            bf16* O; int ldc, ct; bool sg;
            if (pn < 8) { O = ussm; ldc = DSSM; ct = pn; sg = false; } else if (pn < 16) { O = cb; ldc = DCONV; ct = pn - 8; sg = false; }
            else if (pn < 48) { O = ga; ldc = DM; ct = pn - 32; sg = true; } else { O = gb; ldc = DM; ct = pn - 48; sg = true; }
            const int col0 = ct * BM + wc * 32 + 8 * fq;
#pragma unroll
            for (int ai = 0; ai < 2; ++ai)
#pragma unroll
                for (int m = 0; m < 4; ++m) { const int rl = ai * HALF + wr * 64 + m * 16 + fr; const float s = rstd[rl];
                    bf16* rowp = O + (size_t)(u.pm * BM + rl) * ldc + col0;
#pragma unroll
                    for (int bj = 0; bj < 2; ++bj) { f32x4 v0 = acc[ai][bj][m][0] * s, v1 = acc[ai][bj][m][1] * s;
                        if (sg) {
#pragma unroll
                            for (int j = 0; j < 4; ++j) { v0[j] = sigmoidf_(v0[j]); v1[j] = sigmoidf_(v1[j]); } }
                        u32x4 w; w.x = cvt_pk_bf16(v0[0], v0[1]); w.y = cvt_pk_bf16(v0[2], v0[3]); w.z = cvt_pk_bf16(v1[0], v1[1]); w.w = cvt_pk_bf16(v1[2], v1[3]);
                        *(u32x4*)(rowp + bj * HALF) = w; } }
        }
    }
};
struct EpiMixI8 {
    bf16* ussm; bf16* cb; bf16* ga; bf16* gb; const LAS float* rowfac; const float* colsc;
    __device__ __forceinline__ void operator()(const Acc& acc, const Unit& u, int wr, int wc, int fr, int fq) const {
        const int pn = u.pn + (u.pn >= 16 ? 16 : 0), nt0 = pn * BM + wc * 32 + 8 * fq;
        f32x4 cs[2][2];
#pragma unroll
        for (int bj = 0; bj < 2; ++bj)
#pragma unroll
            for (int n = 0; n < 2; ++n) cs[bj][n] = *(const GAS f32x4*)(colsc + nt0 + bj * HALF + 4 * n);
        bf16* O; int ldc, ct; bool sg;
        if (pn < 8) { O = ussm; ldc = DSSM; ct = pn; sg = false; } else if (pn < 16) { O = cb; ldc = DCONV; ct = pn - 8; sg = false; }
        else if (pn < 48) { O = ga; ldc = DM; ct = pn - 32; sg = true; } else { O = gb; ldc = DM; ct = pn - 48; sg = true; }
        const int col0 = ct * BM + wc * 32 + 8 * fq;
#pragma unroll
        for (int ai = 0; ai < 2; ++ai)
#pragma unroll
            for (int m = 0; m < 4; ++m) { const int rl = ai * HALF + wr * 64 + m * 16 + fr; const float rf = rowfac[rl];
                bf16* rowp = O + (size_t)(u.pm * BM + rl) * ldc + col0;
#pragma unroll
                for (int bj = 0; bj < 2; ++bj) { const v4i i0 = __builtin_bit_cast(v4i, acc[ai][bj][m][0]), i1 = __builtin_bit_cast(v4i, acc[ai][bj][m][1]); f32x4 v0, v1;
#pragma unroll
                    for (int j = 0; j < 4; ++j) { v0[j] = (float)i0[j] * (rf * cs[bj][0][j]); v1[j] = (float)i1[j] * (rf * cs[bj][1][j]); }
                    if (sg) {
#pragma unroll
                        for (int j = 0; j < 4; ++j) { v0[j] = sigmoidf_(v0[j]); v1[j] = sigmoidf_(v1[j]); } }
                    u32x4 w; w.x = cvt_pk_bf16(v0[0], v0[1]); w.y = cvt_pk_bf16(v0[2], v0[3]); w.z = cvt_pk_bf16(v1[0], v1[1]); w.w = cvt_pk_bf16(v1[2], v1[3]);
                    *(u32x4*)(rowp + bj * HALF) = w; } }
    }
};
struct EpiZc {
    bf16* zc; const LAS float* rstd;
    __device__ __forceinline__ void operator()(const Acc& acc, const Unit& u, int wr, int wc, int fr, int fq) const {
        const int col0 = u.pn * HALF + wc * 32 + 8 * fq;
#pragma unroll
        for (int ai = 0; ai < 2; ++ai)
#pragma unroll
            for (int m = 0; m < 4; ++m) { const int rl = ai * HALF + wr * 64 + m * 16 + fr; const float s = rstd[rl]; float o[8];
#pragma unroll
                for (int n = 0; n < 2; ++n)
#pragma unroll
                    for (int j = 0; j < 4; ++j) o[n * 4 + j] = (acc[ai][0][m][n][j] * s) * (acc[ai][1][m][n][j] * s);
                u32x4 w; w.x = cvt_pk_bf16(o[0], o[1]); w.y = cvt_pk_bf16(o[2], o[3]); w.z = cvt_pk_bf16(o[4], o[5]); w.w = cvt_pk_bf16(o[6], o[7]);
                *(u32x4*)(zc + (size_t)(u.pm * BM + rl) * DCONV + col0) = w; }
    }
};
struct EpiGate8 {
    bf16* ga; bf16* gb; const LAS float* rstd;
    __device__ __forceinline__ void operator()(const Acc& acc, const Unit& u, int wr, int wc, int fr, int fq) const {
        bf16* O = u.pn < 16 ? ga : gb; const int col0 = (u.pn & 15) * BM + wc * 32 + 8 * fq;
#pragma unroll
        for (int ai = 0; ai < 2; ++ai)
#pragma unroll
            for (int m = 0; m < 4; ++m) { const int rl = ai * HALF + wr * 64 + m * 16 + fr; const float s = rstd[rl] * 0.00390625f;
                bf16* rowp = O + (size_t)(u.pm * BM + rl) * DM + col0;
#pragma unroll
                for (int bj = 0; bj < 2; ++bj) { f32x4 v0 = acc[ai][bj][m][0] * s, v1 = acc[ai][bj][m][1] * s;
#pragma unroll
                    for (int j = 0; j < 4; ++j) { v0[j] = sigmoidf_(v0[j]); v1[j] = sigmoidf_(v1[j]); }
                    u32x4 w; w.x = cvt_pk_bf16(v0[0], v0[1]); w.y = cvt_pk_bf16(v0[2], v0[3]); w.z = cvt_pk_bf16(v1[0], v1[1]); w.w = cvt_pk_bf16(v1[2], v1[3]);
                    *(u32x4*)(rowp + bj * HALF) = w; } }
    }
};
struct EpiConvOut {
    const bf16* gb; bf16* tmp;
    __device__ __forceinline__ void operator()(const Acc& acc, const Unit& u, int wr, int wc, int fr, int fq) const {
        const int col0 = u.pn * BM + wc * 32 + 8 * fq;
#pragma unroll
        for (int ai = 0; ai < 2; ++ai)
#pragma unroll
            for (int m = 0; m < 4; ++m) { const size_t off = (size_t)(u.pm * BM + ai * HALF + wr * 64 + m * 16 + fr) * DM + col0;
#pragma unroll
                for (int bj = 0; bj < 2; ++bj) { const u32x4 g = *(const u32x4*)(gb + off + bj * HALF); const f32x4 a0 = acc[ai][bj][m][0], a1 = acc[ai][bj][m][1];
                    u32x4 w; w.x = cvt_pk_bf16(bf_lo(g.x) * a0[0], bf_hi(g.x) * a0[1]); w.y = cvt_pk_bf16(bf_lo(g.y) * a0[2], bf_hi(g.y) * a0[3]);
                    w.z = cvt_pk_bf16(bf_lo(g.z) * a1[0], bf_hi(g.z) * a1[1]); w.w = cvt_pk_bf16(bf_lo(g.w) * a1[2], bf_hi(g.w) * a1[3]);
                    *(u32x4*)(tmp + off + bj * HALF) = w; }
                asm volatile("" ::: "memory"); }
    }
};
struct EpiGlu {
    const bf16* ga; bf16* tmp;
    __device__ __forceinline__ void operator()(const Acc& acc, const Unit& u, int wr, int wc, int fr, int fq) const {
        const int col0 = u.pn * HALF + wc * 32 + 8 * fq;
#pragma unroll
        for (int ai = 0; ai < 2; ++ai)
#pragma unroll
            for (int m = 0; m < 4; ++m) { const size_t off = (size_t)(u.pm * BM + ai * HALF + wr * 64 + m * 16 + fr) * DM + col0;
                const u32x4 g = *(const u32x4*)(ga + off), t = *(const u32x4*)(tmp + off);
                const unsigned gw[4] = {g.x, g.y, g.z, g.w}, tw[4] = {t.x, t.y, t.z, t.w}; unsigned ow[4];
#pragma unroll
                for (int h = 0; h < 4; ++h) { const int n = h >> 1, j = (h & 1) * 2;
                    const float ya0 = acc[ai][0][m][n][j] * sigmoidf_(acc[ai][1][m][n][j]), ya1 = acc[ai][0][m][n][j + 1] * sigmoidf_(acc[ai][1][m][n][j + 1]);
                    ow[h] = cvt_pk_bf16(bf_lo(tw[h]) + bf_lo(gw[h]) * ya0, bf_hi(tw[h]) + bf_hi(gw[h]) * ya1); }
                u32x4 w; w.x = ow[0]; w.y = ow[1]; w.z = ow[2]; w.w = ow[3];
                *(u32x4*)(tmp + off) = w;
                asm volatile("" ::: "memory"); }
    }
};
}

#define XB_TMO      128
#define XB_XCNT(j)  (256  + 64 * (j))
#define XB_XSUB(j)  (1280 + 64 * (j))
#define XB_XGEN(j)  (2304 + 64 * (j))
#define XB_TOP      3328
#define XB_TOPGEN   3392
#define XCD_BAR_WORDS 3456
#define XB_SPIN_CAP (1u << 18)
__device__ __forceinline__ unsigned xb_ld(unsigned* p)              { return __hip_atomic_load(p, __ATOMIC_RELAXED, __HIP_MEMORY_SCOPE_AGENT); }
__device__ __forceinline__ unsigned xb_add(unsigned* p, unsigned v) { return __hip_atomic_fetch_add(p, v, __ATOMIC_RELAXED, __HIP_MEMORY_SCOPE_AGENT); }
__device__ __forceinline__ unsigned xb_xcc_id() { return (unsigned)__builtin_amdgcn_s_getreg((3 << 11) | 20) & 0xFu; }
#define XB_SPIN(cond, bar) do { unsigned _sp = 0; while (cond) { __builtin_amdgcn_s_sleep(1); \
    if ((++_sp & 255u) == 0u) { if (xb_ld(&(bar)[XB_TMO])) break; if (_sp > XB_SPIN_CAP) { atomicAdd(&(bar)[XB_TMO], 1u); break; } } } } while (0)
struct XcdBarrier { unsigned* bar; unsigned x; volatile LAS unsigned* st; };
__device__ __forceinline__ XcdBarrier xcd_barrier_post(unsigned* bar, volatile LAS unsigned* st) {
    XcdBarrier b; b.bar = bar; b.x = xb_xcc_id(); b.st = st;
    if (threadIdx.x == 0) (void)xb_add(&bar[XB_XCNT(b.x)], 1u);
    return b;
}
__device__ __forceinline__ void xcd_barrier_complete(unsigned* bar, unsigned x, unsigned& nloc, unsigned& nx) {
    const unsigned G = gridDim.x * gridDim.y * gridDim.z;
    unsigned sum, cnt, mine, sp = 0u;
    for (;;) {
        sum = 0u; cnt = 0u; mine = 0u;
#pragma unroll
        for (unsigned j = 0; j < 16; ++j) { const unsigned c = xb_ld(&bar[XB_XCNT(j)]); sum += c; cnt += (c > 0u) ? 1u : 0u; mine = (j == x) ? c : mine; }
        if (sum == G) break;
        __builtin_amdgcn_s_sleep(1);
        if ((++sp & 255u) == 0u) { if (xb_ld(&bar[XB_TMO])) break; if (sp > XB_SPIN_CAP) { atomicAdd(&bar[XB_TMO], 1u); break; } }
    }
    nloc = mine > 0u ? mine : 1u; nx = cnt > 0u ? cnt : 1u;
}
__device__ __forceinline__ void xcd_barrier(const XcdBarrier& b) {
    asm volatile("s_waitcnt vmcnt(0)" ::: "memory");
    __syncthreads();
    if (threadIdx.x == 0) {
        unsigned* bar = b.bar;
        __builtin_amdgcn_s_waitcnt(0);
        unsigned nloc = b.st[0], nx = b.st[1];
        if (nloc == 0u) { xcd_barrier_complete(bar, b.x, nloc, nx); b.st[0] = nloc; b.st[1] = nx; }
        const unsigned old = xb_add(&bar[XB_XSUB(b.x)], 1u);
        const unsigned gen = old / nloc;
        if (old + 1u == (gen + 1u) * nloc) {
            __builtin_amdgcn_fence(__ATOMIC_RELEASE, "agent");
            asm volatile("s_waitcnt vmcnt(0)" ::: "memory");
            const unsigned og = xb_add(&bar[XB_TOP], 1u);
            const unsigned tg = og / nx;
            if (og + 1u == (tg + 1u) * nx) xb_add(&bar[XB_TOPGEN], 1u);
            else XB_SPIN(xb_ld(&bar[XB_TOPGEN]) == tg, bar);
            __builtin_amdgcn_fence(__ATOMIC_ACQUIRE, "agent");
            xb_add(&bar[XB_XGEN(b.x)], 1u);
            asm volatile("s_waitcnt vmcnt(0)" ::: "memory");
        } else {
            XB_SPIN(xb_ld(&bar[XB_XGEN(b.x)]) == gen, bar);
            __builtin_amdgcn_fence(__ATOMIC_ACQUIRE, "agent");
            asm volatile("s_waitcnt vmcnt(0)" ::: "memory");
        }
    }
    __syncthreads();
}

struct Args { const float* in[29]; float* out; unsigned char* ws; int ph_lo, ph_hi; };
enum { I_X = 0, I_MEM, I_F1N, I_F1IN, I_F1OUT, I_MIXN, I_MIXIN, I_ARE, I_AIM, I_LOGDT, I_BRE, I_BIM, I_CRE, I_CIM, I_SSMD, I_GLUW, I_CONVW, I_CONVOUT, I_MIXOUT,
       I_XN, I_MEMN, I_WQ, I_WK, I_WV, I_WO, I_F2N, I_F2IN, I_F2OUT, I_FINN };
constexpr int NPHASE = 17;

__device__ __forceinline__ int rowmap(int mapk, int nb) {
    if (mapk == 1) return nb < 86 ? 256 * nb : 256 * (nb - 86) + 128;
    if (mapk == 2) return nb < 32 ? 128 * nb : (nb < 48 ? 4096 + 256 * (nb - 32) : (nb < 64 ? 4096 + 256 * (nb - 48) + 128 : 128 * nb));
    if (mapk == 3) return nb < 32 ? 256 * nb : 256 * (nb - 32) + 128;
    return 128 * nb;
}
__device__ __forceinline__ void p0_item(const float* W, const float* gain, int K, int N, bf16* WT, int mapk, LAS unsigned* scr, int item, int lane, int nblk_use = 0, int nb0 = 0) {
    const int nblk = nblk_use ? nblk_use : N / 128, kb = item / nblk, nb = nb0 + item % nblk, k0 = 64 * kb, n0 = 128 * nb;
    const int nrow0 = rowmap(mapk, nb);
    const int x = lane & 31, half = lane >> 5;
#pragma unroll 8
    for (int kk = 0; kk < 16; ++kk) {
        const int kp = kk + 16 * half, k = k0 + 2 * kp;
        const f32x4 a = *(const GAS f32x4*)(W + (size_t)k * N + n0 + 4 * x), b = *(const GAS f32x4*)(W + (size_t)(k + 1) * N + n0 + 4 * x);
        const float g0 = gain ? gain[k] : 1.0f, g1 = gain ? gain[k + 1] : 1.0f;
        u32x4 d; d.x = pk2(a.x * g0, b.x * g1); d.y = pk2(a.y * g0, b.y * g1); d.z = pk2(a.z * g0, b.z * g1); d.w = pk2(a.w * g0, b.w * g1);
        *(LAS u32x4*)(scr + kp * 132 + 4 * x) = d;
    }
    LDS_WAIT();
    const int c8 = lane & 7;
#pragma unroll 4
    for (int it = 0; it < 16; ++it) { const int n = it * 8 + (lane >> 3);
        u32x4 o; o.x = scr[(4 * c8 + 0) * 132 + n]; o.y = scr[(4 * c8 + 1) * 132 + n]; o.z = scr[(4 * c8 + 2) * 132 + n]; o.w = scr[(4 * c8 + 3) * 132 + n];
        *(GAS u32x4*)(WT + (size_t)(nrow0 + n) * K + k0 + 8 * c8) = o; }
    LDS_WAIT();
}
__device__ __forceinline__ void p0_item8(const float* W, const float* gain, float sc, int K, int N, int ncol0, int nblk, unsigned char* WT, LAS unsigned* scr, int item, int lane) {
    const int kb = item / nblk, nb = item % nblk, k0 = 128 * kb, n0 = ncol0 + 128 * nb;
    const int x = lane & 31, half = lane >> 5;
#pragma unroll 4
    for (int kk = 0; kk < 16; ++kk) {
        const int kq = kk + 16 * half, k = k0 + 4 * kq;
        f32x4 r[4];
#pragma unroll
        for (int j = 0; j < 4; ++j) r[j] = *(const GAS f32x4*)(W + (size_t)(k + j) * N + n0 + 4 * x) * (gain[k + j] * sc);
        unsigned d[4];
#pragma unroll
        for (int i = 0; i < 4; ++i) { unsigned w = 0u; w = __builtin_amdgcn_cvt_pk_fp8_f32(r[0][i], r[1][i], w, false); w = __builtin_amdgcn_cvt_pk_fp8_f32(r[2][i], r[3][i], w, true); d[i] = w; }
        u32x4 dv; dv.x = d[0]; dv.y = d[1]; dv.z = d[2]; dv.w = d[3];
        *(LAS u32x4*)(scr + kq * 132 + 4 * x) = dv;
    }
    LDS_WAIT();
    const int c8 = lane & 7;
#pragma unroll 4
    for (int it = 0; it < 16; ++it) { const int n = it * 8 + (lane >> 3);
        u32x4 o; o.x = scr[(4 * c8 + 0) * 132 + n]; o.y = scr[(4 * c8 + 1) * 132 + n]; o.z = scr[(4 * c8 + 2) * 132 + n]; o.w = scr[(4 * c8 + 3) * 132 + n];
        *(GAS u32x4*)(WT + (size_t)(128 * nb + n) * K + k0 + 16 * c8) = o; }
    LDS_WAIT();
}
__device__ __forceinline__ unsigned pack_i8x4(float a, float b, float c, float d) {
    const int q0 = (int)__builtin_rintf(a), q1 = (int)__builtin_rintf(b), q2 = (int)__builtin_rintf(c), q3 = (int)__builtin_rintf(d);
    return (unsigned)(q0 & 255) | ((unsigned)(q1 & 255) << 8) | ((unsigned)(q2 & 255) << 16) | ((unsigned)q3 << 24);
}
__device__ __forceinline__ void p0_colmax_item(const float* W, const float* gain, int N, int mapk, unsigned* colmax, int item, int lane, bool skip32 = false) {
    const int nblk = N / 128 - (skip32 ? 32 : 0), kb = item / nblk, nbr = item % nblk, nb = nbr + ((skip32 && nbr >= 32) ? 32 : 0), k0 = 128 * kb, n0 = 128 * nb, nrow0 = rowmap(mapk, nb);
    const int x = lane & 31, half = lane >> 5;
    float m0 = 0.f, m1 = 0.f, m2 = 0.f, m3 = 0.f;
#pragma unroll 8
    for (int kk = 0; kk < 64; ++kk) { const int k = k0 + 2 * kk + half;
        const f32x4 a = __builtin_nontemporal_load((const GAS f32x4*)(W + (size_t)k * N + n0 + 4 * x)) * gain[k];
        m0 = fmaxf(m0, fabsf(a.x)); m1 = fmaxf(m1, fabsf(a.y)); m2 = fmaxf(m2, fabsf(a.z)); m3 = fmaxf(m3, fabsf(a.w)); }
    m0 = fmaxf(m0, __shfl_xor(m0, 32)); m1 = fmaxf(m1, __shfl_xor(m1, 32)); m2 = fmaxf(m2, __shfl_xor(m2, 32)); m3 = fmaxf(m3, __shfl_xor(m3, 32));
    if (half == 0) { unsigned* c = colmax + nrow0 + 4 * x;
        atomicMax(c + 0, __builtin_bit_cast(unsigned, m0)); atomicMax(c + 1, __builtin_bit_cast(unsigned, m1)); atomicMax(c + 2, __builtin_bit_cast(unsigned, m2)); atomicMax(c + 3, __builtin_bit_cast(unsigned, m3)); }
}
__device__ __forceinline__ void p0_item_i8(const float* W, const float* gain, int K, int N, int mapk, const unsigned* colmax, float* colsc, unsigned char* WT, LAS unsigned* scr, int item, int lane, bool skip32 = false) {
    const int nblk = N / 128 - (skip32 ? 32 : 0), kb = item / nblk, nbr = item % nblk, nb = nbr + ((skip32 && nbr >= 32) ? 32 : 0), k0 = 128 * kb, n0 = 128 * nb, nrow0 = rowmap(mapk, nb);
    const int x = lane & 31, half = lane >> 5;
    float inv[4];
#pragma unroll
    for (int i = 0; i < 4; ++i) { const float cm = __builtin_bit_cast(float, __hip_atomic_load(colmax + nrow0 + 4 * x + i, __ATOMIC_RELAXED, __HIP_MEMORY_SCOPE_AGENT)); inv[i] = cm > 0.f ? 127.0f / cm : 0.f;
        if (kb == 0 && half == 0) colsc[nrow0 + 4 * x + i] = cm > 0.f ? cm * (1.0f / 127.0f) : 1.0f; }
#pragma unroll 4
    for (int kk = 0; kk < 16; ++kk) {
        const int kq = kk + 16 * half, k = k0 + 4 * kq;
        f32x4 r[4];
#pragma unroll
        for (int j = 0; j < 4; ++j) r[j] = __builtin_nontemporal_load((const GAS f32x4*)(W + (size_t)(k + j) * N + n0 + 4 * x)) * gain[k + j];
        u32x4 dv; dv.x = pack_i8x4(r[0][0] * inv[0], r[1][0] * inv[0], r[2][0] * inv[0], r[3][0] * inv[0]); dv.y = pack_i8x4(r[0][1] * inv[1], r[1][1] * inv[1], r[2][1] * inv[1], r[3][1] * inv[1]);
        dv.z = pack_i8x4(r[0][2] * inv[2], r[1][2] * inv[2], r[2][2] * inv[2], r[3][2] * inv[2]); dv.w = pack_i8x4(r[0][3] * inv[3], r[1][3] * inv[3], r[2][3] * inv[3], r[3][3] * inv[3]);
        *(LAS u32x4*)(scr + kq * 132 + 4 * x) = dv;
    }
    LDS_WAIT();
    const int c8 = lane & 7;
#pragma unroll 4
    for (int it = 0; it < 16; ++it) { const int n = it * 8 + (lane >> 3);
        u32x4 o; o.x = scr[(4 * c8 + 0) * 132 + n]; o.y = scr[(4 * c8 + 1) * 132 + n]; o.z = scr[(4 * c8 + 2) * 132 + n]; o.w = scr[(4 * c8 + 3) * 132 + n];
        *(GAS u32x4*)(WT + (size_t)(nrow0 + n) * K + k0 + 16 * c8) = o; }
    LDS_WAIT();
}
__device__ __forceinline__ void slab_quant_i8(const float* W, const float* gain, int N, int n0, int nrow, unsigned char* WT, float* colsc, LAS float* red, int tid) {
    const int lane = tid & 63, w = tid >> 6, c = lane & 3, rg = lane >> 2, k0 = 512 * w + 32 * rg;
    const GAS float* src = (const GAS float*)W + (size_t)k0 * N + n0 + 4 * c;
    f32x4 v[32];
#pragma unroll
    for (int i = 0; i < 32; ++i) v[i] = *(const GAS f32x4*)(src + (size_t)i * N);
    float m0 = 0.f, m1 = 0.f, m2 = 0.f, m3 = 0.f;
#pragma unroll
    for (int i4 = 0; i4 < 8; ++i4) { const f32x4 g = *(const GAS f32x4*)(gain + k0 + 4 * i4);
#pragma unroll
        for (int e = 0; e < 4; ++e) { const int i = 4 * i4 + e; v[i] = v[i] * g[e];
            m0 = fmaxf(m0, fabsf(v[i].x)); m1 = fmaxf(m1, fabsf(v[i].y)); m2 = fmaxf(m2, fabsf(v[i].z)); m3 = fmaxf(m3, fabsf(v[i].w)); } }
#pragma unroll
    for (int o = 4; o < 64; o <<= 1) { m0 = fmaxf(m0, __shfl_xor(m0, o)); m1 = fmaxf(m1, __shfl_xor(m1, o)); m2 = fmaxf(m2, __shfl_xor(m2, o)); m3 = fmaxf(m3, __shfl_xor(m3, o)); }
    if (rg == 0) { red[w * 16 + 4 * c + 0] = m0; red[w * 16 + 4 * c + 1] = m1; red[w * 16 + 4 * c + 2] = m2; red[w * 16 + 4 * c + 3] = m3; }
    __syncthreads();
    float inv[4];
#pragma unroll
    for (int j = 0; j < 4; ++j) { float cm = 0.f;
#pragma unroll
        for (int ww = 0; ww < 8; ++ww) cm = fmaxf(cm, red[ww * 16 + 4 * c + j]);
        inv[j] = cm > 0.f ? 127.0f / cm : 0.f;
        if (w == 0 && rg == 0) colsc[nrow + 4 * c + j] = cm > 0.f ? cm * (1.0f / 127.0f) : 1.0f; }
#pragma unroll
    for (int j = 0; j < 4; ++j) { GAS u32x4* dst = (GAS u32x4*)(WT + (size_t)(nrow + 4 * c + j) * 4096 + k0);
#pragma unroll
        for (int h = 0; h < 2; ++h) { u32x4 o;
            o.x = pack_i8x4(v[16 * h + 0][j] * inv[j], v[16 * h + 1][j] * inv[j], v[16 * h + 2][j] * inv[j], v[16 * h + 3][j] * inv[j]);
            o.y = pack_i8x4(v[16 * h + 4][j] * inv[j], v[16 * h + 5][j] * inv[j], v[16 * h + 6][j] * inv[j], v[16 * h + 7][j] * inv[j]);
            o.z = pack_i8x4(v[16 * h + 8][j] * inv[j], v[16 * h + 9][j] * inv[j], v[16 * h + 10][j] * inv[j], v[16 * h + 11][j] * inv[j]);
            o.w = pack_i8x4(v[16 * h + 12][j] * inv[j], v[16 * h + 13][j] * inv[j], v[16 * h + 14][j] * inv[j], v[16 * h + 15][j] * inv[j]);
            dst[h] = o; } }
}
template <bool HASG = true> __device__ __forceinline__ void slab32_quant_i8(const float* W, const float* gain, int N, int n0, int nrow, unsigned char* WT, float* colsc, LAS float* red, LAS u32x2* spill, int tid) {
    const int lane = tid & 63, w = tid >> 6, c = lane & 7, rg = lane >> 3, k0 = 512 * w + 64 * rg;
    const __amdgpu_buffer_rsrc_t rs = __builtin_amdgcn_make_buffer_rsrc((void*)W, 0, (int)0xffffffffu, 0x00020000);
    const unsigned voff = (unsigned)(k0 * N + n0 + 4 * c) * 4u, rstep = (unsigned)N * 4u;
#define SLAB_LD(i) __builtin_bit_cast(f32x4, __builtin_amdgcn_raw_buffer_load_b128(rs, voff, (unsigned)(i) * rstep, 0))
    constexpr int NR = 30, NBATCH = 8;
    unsigned P[NR][2];
    float m0 = 0.f, m1 = 0.f, m2 = 0.f, m3 = 0.f;
    f32x4 va[NBATCH], vb[NBATCH];
#pragma unroll
    for (int i = 0; i < NBATCH; ++i) va[i] = SLAB_LD(i);
#pragma unroll
    for (int b = 0; b < 64 / NBATCH; ++b) {
        if (b < 64 / NBATCH - 1) {
#pragma unroll
            for (int i = 0; i < NBATCH; ++i) vb[i] = SLAB_LD(NBATCH * (b + 1) + i); }
        __builtin_amdgcn_sched_barrier(0);
#pragma unroll
        for (int i4 = 0; i4 < NBATCH / 4; ++i4) { f32x4 g = {1.f, 1.f, 1.f, 1.f}; if constexpr (HASG) g = *(const GAS f32x4*)(gain + k0 + NBATCH * b + 4 * i4);
#pragma unroll
            for (int e = 0; e < 4; ++e) { const int i = NBATCH * b + 4 * i4 + e; const f32x4 v = va[4 * i4 + e] * g[e];
                m0 = fmaxf(m0, fabsf(v.x)); m1 = fmaxf(m1, fabsf(v.y)); m2 = fmaxf(m2, fabsf(v.z)); m3 = fmaxf(m3, fabsf(v.w));
                const unsigned p0 = cvt_pk_bf16(v.x, v.y), p1 = cvt_pk_bf16(v.z, v.w);
                if (i < NR) { P[i][0] = p0; P[i][1] = p1; } else { u32x2 q; q.x = p0; q.y = p1; spill[(i - NR) * 512 + tid] = q; } } }
        __builtin_amdgcn_sched_barrier(0);
#pragma unroll
        for (int i = 0; i < NBATCH; ++i) va[i] = vb[i];
    }
#undef SLAB_LD
#pragma unroll
    for (int o = 8; o < 64; o <<= 1) { m0 = fmaxf(m0, __shfl_xor(m0, o)); m1 = fmaxf(m1, __shfl_xor(m1, o)); m2 = fmaxf(m2, __shfl_xor(m2, o)); m3 = fmaxf(m3, __shfl_xor(m3, o)); }
    if (rg == 0) { red[w * 32 + 4 * c + 0] = m0; red[w * 32 + 4 * c + 1] = m1; red[w * 32 + 4 * c + 2] = m2; red[w * 32 + 4 * c + 3] = m3; }
    __syncthreads();
    float inv[4];
#pragma unroll
    for (int j = 0; j < 4; ++j) { float cm = 0.f;
#pragma unroll
        for (int ww = 0; ww < 8; ++ww) cm = fmaxf(cm, red[ww * 32 + 4 * c + j]);
        inv[j] = cm > 0.f ? 127.0f / cm : 0.f;
        if (w == 0 && rg == 0) colsc[nrow + 4 * c + j] = cm > 0.f ? cm * (1.0f / 127.0f) : 1.0f; }
#pragma unroll
    for (int h = 0; h < 4; ++h) { unsigned o[4][4];
#pragma unroll
        for (int d = 0; d < 4; ++d) { unsigned q0[4], q1[4];
#pragma unroll
            for (int e = 0; e < 4; ++e) { const int i = 16 * h + 4 * d + e;
                if (i < NR) { q0[e] = P[i][0]; q1[e] = P[i][1]; } else { const u32x2 q = spill[(i - NR) * 512 + tid]; q0[e] = q.x; q1[e] = q.y; } }
            o[0][d] = pack_i8x4(bf_lo(q0[0]) * inv[0], bf_lo(q0[1]) * inv[0], bf_lo(q0[2]) * inv[0], bf_lo(q0[3]) * inv[0]);
            o[1][d] = pack_i8x4(bf_hi(q0[0]) * inv[1], bf_hi(q0[1]) * inv[1], bf_hi(q0[2]) * inv[1], bf_hi(q0[3]) * inv[1]);
            o[2][d] = pack_i8x4(bf_lo(q1[0]) * inv[2], bf_lo(q1[1]) * inv[2], bf_lo(q1[2]) * inv[2], bf_lo(q1[3]) * inv[2]);
            o[3][d] = pack_i8x4(bf_hi(q1[0]) * inv[3], bf_hi(q1[1]) * inv[3], bf_hi(q1[2]) * inv[3], bf_hi(q1[3]) * inv[3]); }
#pragma unroll
        for (int j = 0; j < 4; ++j) { u32x4 ov; ov.x = o[j][0]; ov.y = o[j][1]; ov.z = o[j][2]; ov.w = o[j][3];
            *(GAS u32x4*)(WT + (size_t)(nrow + 4 * c + j) * 4096 + k0 + 16 * h) = ov; } }
}
__device__ __forceinline__ void row_quant_i8(const float* xrow, bf16* orow, unsigned char* qrow, float* rowfac, int lane) {
    const GAS f32x4* xr = (const GAS f32x4*)xrow + lane;
    f32x4 v[16]; float s = 0.f, mx = 0.f;
#pragma unroll
    for (int j = 0; j < 16; ++j) { v[j] = __builtin_nontemporal_load(xr + 64 * j); s += (v[j].x * v[j].x + v[j].y * v[j].y) + (v[j].z * v[j].z + v[j].w * v[j].w);
        mx = fmaxf(mx, fmaxf(fmaxf(fabsf(v[j].x), fabsf(v[j].y)), fmaxf(fabsf(v[j].z), fabsf(v[j].w)))); }
    s = wave_sum(s); mx = wave_max(mx);
    const float inv = mx > 0.f ? 127.0f / mx : 0.f;
    if (lane == 0) *rowfac = (mx > 0.f ? mx * (1.0f / 127.0f) : 1.0f) / sqrtf(s * (1.0f / DM) + RMS_EPS);
    GAS u32x2* o8 = (GAS u32x2*)orow + lane; GAS unsigned* q4 = (GAS unsigned*)qrow + lane;
#pragma unroll
    for (int j = 0; j < 16; ++j) { if (orow) { u32x2 o; o.x = pk2(v[j].x, v[j].y); o.y = pk2(v[j].z, v[j].w); o8[64 * j] = o; } q4[64 * j] = pack_i8x4(v[j].x * inv, v[j].y * inv, v[j].z * inv, v[j].w * inv); }
}
__device__ __forceinline__ void row_quant_bf16_i8(const bf16* xrow, const float* stat_row, unsigned char* qrow, float* rowfac, int lane) {
    const GAS u32x2* xr = (const GAS u32x2*)xrow + lane;
    f32x4 v[16]; float mx = 0.f;
#pragma unroll
    for (int j = 0; j < 16; ++j) { const u32x2 w = xr[64 * j]; v[j] = (f32x4){bf_lo(w.x), bf_hi(w.x), bf_lo(w.y), bf_hi(w.y)};
        mx = fmaxf(mx, fmaxf(fmaxf(fabsf(v[j].x), fabsf(v[j].y)), fmaxf(fabsf(v[j].z), fabsf(v[j].w)))); }
    const float s = wave_sum(((const GAS float*)stat_row)[lane]); mx = wave_max(mx);
    const float inv = mx > 0.f ? 127.0f / mx : 0.f;
    if (lane == 0) *rowfac = (mx > 0.f ? mx * (1.0f / 127.0f) : 1.0f) / sqrtf(s * (1.0f / DM) + RMS_EPS);
    GAS unsigned* q4 = (GAS unsigned*)qrow + lane;
#pragma unroll
    for (int j = 0; j < 16; ++j) q4[64 * j] = pack_i8x4(v[j].x * inv, v[j].y * inv, v[j].z * inv, v[j].w * inv);
}
__device__ __forceinline__ void row_norm_quant_i8(const float* xrow, const float* gain, unsigned char* qrow, float* rowfac, int lane) {
    const GAS f32x4* xr = (const GAS f32x4*)xrow + lane;
    f32x4 v[16]; float s = 0.f, mx = 0.f;
#pragma unroll
    for (int j = 0; j < 16; ++j) { v[j] = xr[64 * j]; s += (v[j].x * v[j].x + v[j].y * v[j].y) + (v[j].z * v[j].z + v[j].w * v[j].w); }
    const float sc = 1.0f / sqrtf(wave_sum(s) * (1.0f / DM) + RMS_EPS);
#pragma unroll
    for (int j = 0; j < 16; ++j) { const f32x4 g = ((const GAS f32x4*)gain)[lane + 64 * j]; v[j] = v[j] * sc * g;
        mx = fmaxf(mx, fmaxf(fmaxf(fabsf(v[j].x), fabsf(v[j].y)), fmaxf(fabsf(v[j].z), fabsf(v[j].w)))); }
    mx = wave_max(mx);
    const float inv = mx > 0.f ? 127.0f / mx : 0.f;
    if (lane == 0) *rowfac = mx > 0.f ? mx * (1.0f / 127.0f) : 1.0f;
    GAS unsigned* q4 = (GAS unsigned*)qrow + lane;
#pragma unroll
    for (int j = 0; j < 16; ++j) q4[64 * j] = pack_i8x4(v[j].x * inv, v[j].y * inv, v[j].z * inv, v[j].w * inv);
}
__device__ __forceinline__ void row_to_bf16(const float* xrow, bf16* orow, float* stat_row, const float* gain, int lane) {
    const GAS f32x4* xr = (const GAS f32x4*)xrow + lane;
    f32x4 v[16]; float s = 0.f;
#pragma unroll
    for (int j = 0; j < 16; ++j) { v[j] = xr[64 * j]; s += (v[j].x * v[j].x + v[j].y * v[j].y) + (v[j].z * v[j].z + v[j].w * v[j].w); }
    s = wave_sum(s);
    float sc = 1.0f;
    if (gain) sc = 1.0f / sqrtf(s * (1.0f / DM) + RMS_EPS);
    if (stat_row) stat_row[lane] = (lane == 0) ? s : 0.f;
    GAS u32x2* o8 = (GAS u32x2*)orow + lane;
#pragma unroll
    for (int j = 0; j < 16; ++j) { f32x4 w = v[j] * sc;
        if (gain) { const f32x4 g = ((const GAS f32x4*)gain)[lane + 64 * j]; w = w * g; }
        u32x2 o; o.x = pk2(w.x, w.y); o.y = pk2(w.z, w.w); o8[64 * j] = o; }
}
__device__ __forceinline__ void row_scale_to_bf16(const float* xrow, bf16* orow, float sc, int lane) {
    const GAS f32x4* xr = (const GAS f32x4*)xrow + lane; GAS u32x2* o8 = (GAS u32x2*)orow + lane;
#pragma unroll
    for (int j = 0; j < 16; ++j) { const f32x4 w = xr[64 * j] * sc; u32x2 o; o.x = pk2(w.x, w.y); o.y = pk2(w.z, w.w); o8[64 * j] = o; }
}
__device__ __forceinline__ void rstd_table(const float* stats, int pm, LAS float* tab) {
    const int t = threadIdx.x, row = t >> 1, hf = t & 1;
    const GAS f32x4* p = (const GAS f32x4*)(stats + (size_t)(pm * 256 + row) * 64 + hf * 32);
    float s = 0.f;
#pragma unroll
    for (int j = 0; j < 8; ++j) { const f32x4 v = p[j]; s += (v.x + v.y) + (v.z + v.w); }
    s += __shfl_xor(s, 1);
    if (hf == 0) tab[row] = 1.0f / sqrtf(s * (1.0f / DM) + RMS_EPS);
    __syncthreads();
}


constexpr int SSM_NSEG = 4, SSM_SEGLEN = SEQ / SSM_NSEG;
template <bool FULL>
__device__ __forceinline__ void ssm_unit(LAS unsigned char* wl, const unsigned char* ws, const bf16* ussm, bf16* ys, const float* dskip, int b, int g, int seg, int lane) {
    const int tok = lane & 15, q = lane >> 4;
    LAS float* Vl = (LAS float*)wl;
    LAS unsigned char* Sl = wl + 8448;
    const float* LAM = (const float*)(ws + WS_SSMC); const bf16x8* BFR = (const bf16x8*)(ws + WS_SSMC + 128 * 1024); const bf16x8* CFR = (const bf16x8*)(ws + WS_SSMC + 1152 * 1024);
    float* ESEG = (float*)(ws + WS_ESEG);
    const float lr = LAM[2 * (g * GP + lane)], li = LAM[2 * (g * GP + lane) + 1];
    bf16x8 Bf[8], Cf[4];
#pragma unroll
    for (int mt = 0; mt < 8; ++mt) Bf[mt] = BFR[(g * 8 + mt) * 64 + lane];
    float dsk[4];
    if (FULL) {
#pragma unroll
        for (int ks = 0; ks < 4; ++ks) Cf[ks] = CFR[(g * 4 + ks) * 64 + lane];
#pragma unroll
        for (int r = 0; r < 4; ++r) dsk[r] = dskip[g * GH + 4 * q + r];
    }
    float sr = 0.f, si = 0.f;
    if (FULL && seg > 0) {
        float pr = lr, pi = li;
#pragma unroll
        for (int k = 0; k < 10; ++k) { const float nr = pr * pr - pi * pi, ni = 2.0f * pr * pi; pr = nr; pi = ni; }
        static_assert(SSM_SEGLEN == 1024, "lam^SEGLEN by 10 squarings");
        for (int j = 0; j < seg; ++j) { const f32x2 e = *(const GAS f32x2*)(ESEG + ((size_t)((b * NG + g) * SSM_NSEG + j) * GP + lane) * 2);
            const float nr = pr * sr - pi * si + e.x, ni = pr * si + pi * sr + e.y; sr = nr; si = ni; }
    }
    const bf16* ub = ussm + ((size_t)b * SEQ + (size_t)seg * SSM_SEGLEN) * DSSM + g * GH;
    bf16* yb = ys + ((size_t)b * SEQ + (size_t)seg * SSM_SEGLEN) * DSSM + g * GH;
    const bf16x8 zero8 = {0, 0, 0, 0, 0, 0, 0, 0};
    bf16x8 unext = (q < 2) ? *(const GAS bf16x8*)(ub + (size_t)tok * DSSM + 8 * q) : zero8;
    u32x2 snext = {0u, 0u};
    if (FULL) snext = *(const GAS u32x2*)(ub + (size_t)tok * DSSM + 4 * q);
    for (int c = 0; c < SSM_SEGLEN / 16; ++c) {
        const bf16x8 ucur = unext; const u32x2 scur = snext;
        if (c + 1 < SSM_SEGLEN / 16) { const size_t ro = (size_t)(16 * (c + 1) + tok) * DSSM;
            unext = (q < 2) ? *(const GAS bf16x8*)(ub + ro + 8 * q) : zero8; if (FULL) snext = *(const GAS u32x2*)(ub + ro + 4 * q); }
#pragma unroll
        for (int mt = 0; mt < 8; ++mt) { const f32x4 d = __builtin_amdgcn_mfma_f32_16x16x32_bf16(Bf[mt], ucur, (f32x4){0.f, 0.f, 0.f, 0.f}, 0, 0, 0);
            *(LAS f32x4*)(Vl + tok * 132 + 16 * mt + 4 * q) = d; }
        LDS_WAIT();
#pragma unroll
        for (int t = 0; t < 16; ++t) { const f32x2 v = *(const LAS f32x2*)(Vl + t * 132 + 2 * lane);
            const float nr = lr * sr - li * si + v.x, ni = lr * si + li * sr + v.y; sr = nr; si = ni;
            if (FULL) *(LAS unsigned*)(Sl + t * 272 + lane * 4) = cvt_pk_bf16(sr, si); }
        LDS_WAIT();
        if (FULL) {
            f32x4 y = {0.f, 0.f, 0.f, 0.f};
#pragma unroll
            for (int ks = 0; ks < 4; ++ks) { const bf16x8 sf = *(const LAS bf16x8*)(Sl + tok * 272 + (32 * ks + 8 * q) * 2);
                y = __builtin_amdgcn_mfma_f32_16x16x32_bf16(Cf[ks], sf, y, 0, 0, 0); }
            const float u0 = bf_lo(scur.x), u1 = bf_hi(scur.x), u2 = bf_lo(scur.y), u3 = bf_hi(scur.y);
            const float o0 = gelu1(y[0] + dsk[0] * u0), o1 = gelu1(y[1] + dsk[1] * u1), o2 = gelu1(y[2] + dsk[2] * u2), o3 = gelu1(y[3] + dsk[3] * u3);
            u32x2 w; w.x = cvt_pk_bf16(o0, o1); w.y = cvt_pk_bf16(o2, o3);
            *(GAS u32x2*)(yb + (size_t)(16 * c + tok) * DSSM + 4 * q) = w;
        }
    }
    if (!FULL) { f32x2 e; e.x = sr; e.y = si; *(GAS f32x2*)(ESEG + ((size_t)((b * NG + g) * SSM_NSEG + seg) * GP + lane) * 2) = e; }
}

__global__ void __launch_bounds__(NWAVES * 64, 2) mk_fwd(Args args) {
    extern __shared__ __attribute__((aligned(16))) unsigned char lds_raw[];
    LAS unsigned char* lds = (LAS unsigned char*)lds_raw;
    volatile LAS unsigned* MISC = (volatile LAS unsigned*)(lds + MISC_OFF);
    LAS float* rstd_tab = (LAS float*)(lds + RSTD_OFF);
#define FRESH_IDS() int tid = threadIdx.x; asm volatile("" : "+v"(tid)); const int lane = tid & 63, wave = __builtin_amdgcn_readfirstlane(tid >> 6); const int gw = bid * NWAVES + wave; (void)lane; (void)gw
    const int G = gridDim.x, bid = blockIdx.x;
    unsigned char* ws = args.ws;
    gu32* ctl = (gu32*)(ws + WS_CTL);
    for (int u = threadIdx.x; u < (LDS_BYTES - RSTD_OFF) / 4; u += NWAVES * 64) ((LAS unsigned*)(lds + RSTD_OFF))[u] = 0u;
    __syncthreads();
    XcdBarrier bar; bar.bar = (unsigned*)(ctl + CW_BAR); bar.x = 0; bar.st = nullptr;
    if (MK_ONE_LAUNCH) bar = xcd_barrier_post((unsigned*)(ctl + CW_BAR), MISC + 8);
    const int lo = args.ph_lo, hi = args.ph_hi;
#define IN(k) (lo <= (k) && (k) < hi)
#define SEAM(k) do { if (IN(k) && IN((k) + 1)) xcd_barrier(bar); } while (0)

    float* const hres = args.out;
    float* const stats = (float*)(ws + WS_STATS);
    bf16* const xb = (bf16*)(ws + WS_XB);
    unsigned char* const big = ws + WS_BIG;
    const int NGW = G * NWAVES;

    if (IN(0)) {
        FRESH_IDS();
        LAS unsigned* scr = (LAS unsigned*)(lds + wave * 16896);
        constexpr int I_FIN = (DM / 64) * (2 * DFF / 128), I_FOUT = (DFF / 64) * (DM / 128), I_MIX = (DM / 64) * 64, I_MIX8 = (DM / 128) * 64, I_GLU = (DSSM / 64) * (2 * DM / 128),
                      I_CO = (DCONV / 64) * (DM / 128), I_SQ = (DM / 64) * (DM / 128);
        constexpr int I_CM = (DM / 128) * (2 * DFF / 128);
        constexpr int I_CMX = (DM / 128) * (MIXC / 128 - 32);
        constexpr int I_MXB = (DM / 64) * 32;
#if MK_SLABQ
        {
            constexpr int NS_F = 2 * DFF / 32, NS_M = (MIXC - DM) / 32, NS_KV = MK_I8_KV ? 2 * DM / 32 : 0, NS = 2 * NS_F + NS_M + NS_KV;
            int itn = 0;
            for (int sl = bid; sl < NS; sl += G, ++itn) {
                LAS float* red = (LAS float*)lds + (itn & 1) * 256;
                LAS u32x2* sp2 = (LAS u32x2*)(lds + 4096);
                if (sl < NS_F) { const int nb = sl >> 2;
                    slab32_quant_i8(args.in[I_F1IN], args.in[I_F1N], 2 * DFF, 32 * sl, rowmap(1, nb) + 32 * (sl & 3), ws + WS_W1IN, (float*)(ws + WS_COLSC1), red, sp2, threadIdx.x); }
                else if (sl < NS_F + NS_M) { const int t = sl - NS_F, nbr = t >> 2, nb = nbr + (nbr >= 32 ? 32 : 0);
                    slab32_quant_i8(args.in[I_MIXIN], args.in[I_MIXN], MIXC, 128 * nb + 32 * (t & 3), rowmap(2, nb) + 32 * (t & 3), ws + WS_WMIX, (float*)(ws + WS_COLSC3), red, sp2, threadIdx.x); }
                else if (sl < 2 * NS_F + NS_M) { const int t = sl - NS_F - NS_M, nb = t >> 2;
                    slab32_quant_i8(args.in[I_F2IN], args.in[I_F2N], 2 * DFF, 32 * t, rowmap(1, nb) + 32 * (t & 3), ws + WS_W2IN, (float*)(ws + WS_COLSC2), red, sp2, threadIdx.x); }
                else if (sl < 2 * NS_F + NS_M + DM / 32) { const int t = sl - 2 * NS_F - NS_M;
                    slab32_quant_i8<false>(args.in[I_WK], nullptr, DM, 32 * t, 32 * t, ws + WS_WK, (float*)(ws + WS_COLSC4), red, sp2, threadIdx.x); }
                else { const int t = sl - 2 * NS_F - NS_M - DM / 32;
                    slab32_quant_i8<false>(args.in[I_WV], nullptr, DM, 32 * t, DM + 32 * t, ws + WS_WK, (float*)(ws + WS_COLSC4), red, sp2, threadIdx.x); }
            }
            __syncthreads();
        }
        constexpr int NITEMS = 2 * I_FOUT + I_MXB + I_GLU + I_CO + (MK_I8_KV ? 2 : 4) * I_SQ;
        for (int it = gw; it < NITEMS; it += NGW) {
            int r = it;
            if (r < I_FOUT) { p0_item(args.in[I_F1OUT], nullptr, DFF, DM, (bf16*)(ws + WS_W1OUT), 0, scr, r, lane); continue; } r -= I_FOUT;
            if (!MK_I8_KV) { if (r < I_SQ) { p0_item(args.in[I_WK], nullptr, DM, DM, (bf16*)(ws + WS_WK), 0, scr, r, lane); continue; } r -= I_SQ;
                             if (r < I_SQ) { p0_item(args.in[I_WV], nullptr, DM, DM, (bf16*)(ws + WS_WV), 0, scr, r, lane); continue; } r -= I_SQ; }
            if (r < I_SQ) { p0_item(args.in[I_WO], nullptr, DM, DM, (bf16*)(ws + WS_WO), 0, scr, r, lane); continue; } r -= I_SQ;
            if (r < I_MXB) { p0_item(args.in[I_MIXIN], args.in[I_MIXN], DM, MIXC, (bf16*)(ws + WS_WMIX + 32 * MiB), 2, scr, r, lane, 32, 32); continue; } r -= I_MXB;
            if (r < I_GLU) { p0_item(args.in[I_GLUW], nullptr, DSSM, 2 * DM, (bf16*)(ws + WS_WGLU), 3, scr, r, lane); continue; } r -= I_GLU;
            if (r < I_CO) { p0_item(args.in[I_CONVOUT], nullptr, DCONV, DM, (bf16*)(ws + WS_WCOUT), 0, scr, r, lane); continue; } r -= I_CO;
            if (r < I_SQ) { p0_item(args.in[I_MIXOUT], nullptr, DM, DM, (bf16*)(ws + WS_WMO), 0, scr, r, lane); continue; } r -= I_SQ;
            p0_item(args.in[I_F2OUT], nullptr, DFF, DM, (bf16*)(ws + WS_W2OUT), 0, scr, r, lane);
        }
#else
        constexpr int NITEMS = ((MK_I8_FFN & 1) ? I_CM : I_FIN) + ((MK_I8_FFN & 2) ? I_CM : I_FIN) + 2 * I_FOUT + (MK_I8_MIX ? I_CMX + I_MXB : (MK_FP8_GATES ? I_MIX + I_MIX8 : 2 * I_MIX)) + I_GLU + I_CO + 4 * I_SQ;
        for (int it = gw; it < NITEMS; it += NGW) {
            int r = it;
            if (MK_I8_FFN & 1) { if (r < I_CM) { p0_colmax_item(args.in[I_F1IN], args.in[I_F1N], 2 * DFF, 1, (unsigned*)(ctl + CW_COLMAX), r, lane); continue; } r -= I_CM; }
            else { if (r < I_FIN) { p0_item(args.in[I_F1IN], args.in[I_F1N], DM, 2 * DFF, (bf16*)(ws + WS_W1IN), 1, scr, r, lane); continue; } r -= I_FIN; }
            if (r < I_FOUT) { p0_item(args.in[I_F1OUT], nullptr, DFF, DM, (bf16*)(ws + WS_W1OUT), 0, scr, r, lane); continue; } r -= I_FOUT;
#if MK_I8_MIX
            if (r < I_CMX) { p0_colmax_item(args.in[I_MIXIN], args.in[I_MIXN], MIXC, 2, (unsigned*)(ctl + CW_COLMAX) + 4 * DFF, r, lane, true); continue; } r -= I_CMX;
            if (r < I_MXB) { p0_item(args.in[I_MIXIN], args.in[I_MIXN], DM, MIXC, (bf16*)(ws + WS_WMIX + 32 * MiB), 2, scr, r, lane, 32, 32); continue; } r -= I_MXB;
#elif MK_FP8_GATES
            if (r < I_MIX) { p0_item(args.in[I_MIXIN], args.in[I_MIXN], DM, MIXC, (bf16*)(ws + WS_WMIX), 2, scr, r, lane, 64); continue; } r -= I_MIX;
            if (r < I_MIX8) { p0_item8(args.in[I_MIXIN], args.in[I_MIXN], 256.0f, DM, MIXC, 8192, 64, ws + WS_WMIX8, scr, r, lane); continue; } r -= I_MIX8;
#else
            if (r < 2 * I_MIX) { p0_item(args.in[I_MIXIN], args.in[I_MIXN], DM, MIXC, (bf16*)(ws + WS_WMIX), 2, scr, r, lane); continue; } r -= 2 * I_MIX;
#endif
            if (r < I_GLU) { p0_item(args.in[I_GLUW], nullptr, DSSM, 2 * DM, (bf16*)(ws + WS_WGLU), 3, scr, r, lane); continue; } r -= I_GLU;
            if (r < I_CO) { p0_item(args.in[I_CONVOUT], nullptr, DCONV, DM, (bf16*)(ws + WS_WCOUT), 0, scr, r, lane); continue; } r -= I_CO;
            if (r < I_SQ) { p0_item(args.in[I_MIXOUT], nullptr, DM, DM, (bf16*)(ws + WS_WMO), 0, scr, r, lane); continue; } r -= I_SQ;
            if (r < I_SQ) { p0_item(args.in[I_WK], nullptr, DM, DM, (bf16*)(ws + WS_WK), 0, scr, r, lane); continue; } r -= I_SQ;
            if (r < I_SQ) { p0_item(args.in[I_WV], nullptr, DM, DM, (bf16*)(ws + WS_WV), 0, scr, r, lane); continue; } r -= I_SQ;
            if (r < I_SQ) { p0_item(args.in[I_WO], nullptr, DM, DM, (bf16*)(ws + WS_WO), 0, scr, r, lane); continue; } r -= I_SQ;
            if (MK_I8_FFN & 2) { if (r < I_CM) { p0_colmax_item(args.in[I_F2IN], args.in[I_F2N], 2 * DFF, 1, (unsigned*)(ctl + CW_COLMAX) + 2 * DFF, r, lane); continue; } r -= I_CM; }
            else { if (r < I_FIN) { p0_item(args.in[I_F2IN], args.in[I_F2N], DM, 2 * DFF, (bf16*)(ws + WS_W2IN), 1, scr, r, lane); continue; } r -= I_FIN; }
            p0_item(args.in[I_F2OUT], nullptr, DFF, DM, (bf16*)(ws + WS_W2OUT), 0, scr, r, lane);
        }
#endif
        if (MK_I8_FFN & 1) { for (int m = gw; m < MTOK; m += NGW) row_quant_i8(args.in[I_X] + (size_t)m * DM, MK_XF32 ? (bf16*)nullptr : xb + (size_t)m * DM, ws + WS_XB8 + (size_t)m * DM, (float*)(ws + WS_ROWFAC) + m, lane); }
        else for (int m = gw; m < MTOK; m += NGW) row_to_bf16(args.in[I_X] + (size_t)m * DM, xb + (size_t)m * DM, stats + (size_t)m * 64, nullptr, lane);
        for (int m = gw; m < DM; m += NGW) row_scale_to_bf16(args.in[I_WQ] + (size_t)m * DM, (bf16*)(ws + WS_WQ) + (size_t)m * DM, args.in[I_XN][m], lane);
        if ((MK_SLABQ & MK_I8_KV) != 0) { for (int m = gw; m < MMEM; m += NGW) row_norm_quant_i8(args.in[I_MEM] + (size_t)m * DM, args.in[I_MEMN], ws + WS_MEMN + (size_t)m * DM, (float*)(ws + WS_ROWFACM) + m, lane); }
        else for (int m = gw; m < MMEM; m += NGW) row_to_bf16(args.in[I_MEM] + (size_t)m * DM, (bf16*)(ws + WS_MEMN) + (size_t)m * DM, nullptr, args.in[I_MEMN], lane);
        {
            float* LAM = (float*)(ws + WS_SSMC); bf16* BFR = (bf16*)(ws + WS_SSMC + 128 * 1024); bf16* CFR = (bf16*)(ws + WS_SSMC + 1152 * 1024);
            const int gt = bid * (NWAVES * 64) + tid, NT = G * NWAVES * 64;
            for (int i = gt; i < NG * GP; i += NT) { const int g = i / GP;
                const double dt = exp((double)args.in[I_LOGDT][g]), ar = (double)args.in[I_ARE][i] * dt, ai = (double)args.in[I_AIM][i] * dt, e = exp(ar);
                LAM[2 * i] = (float)(e * cos(ai)); LAM[2 * i + 1] = (float)(e * sin(ai)); }
            for (int i = gt; i < NG * 8 * 64 * 8; i += NT) { const int j = i & 7, ln = (i >> 3) & 63, mt = (i >> 9) & 7, g = i >> 12; const int q = ln >> 4, pp = 16 * mt + (ln & 15), p = pp >> 1, c = pp & 1;
                float val = 0.f;
                if (q < 2) { const int h = 8 * q + j; const int ip = g * GP + p;
                    const double dt = exp((double)args.in[I_LOGDT][g]), lr = (double)args.in[I_ARE][ip], li = (double)args.in[I_AIM][ip], e = exp(lr * dt);
                    const double zr = e * cos(li * dt) - 1.0, zi = e * sin(li * dt), den = lr * lr + li * li;
                    const double fr_ = (zr * lr + zi * li) / den, fi_ = (zi * lr - zr * li) / den;
                    const double br = (double)args.in[I_BRE][(size_t)ip * GH + h], bi = (double)args.in[I_BIM][(size_t)ip * GH + h];
                    val = (float)(c == 0 ? (fr_ * br - fi_ * bi) : (fr_ * bi + fi_ * br)); }
                BFR[i] = (bf16)f2bf(val); }
            for (int i = gt; i < NG * 4 * 64 * 8; i += NT) { const int j = i & 7, ln = (i >> 3) & 63, ks = (i >> 9) & 3, g = i >> 11; const int q = ln >> 4, o = ln & 15, pp = 32 * ks + 8 * q + j, p = pp >> 1;
                const size_t ic = ((size_t)g * GH + o) * GP + p;
                CFR[i] = (bf16)f2bf((pp & 1) ? -args.in[I_CIM][ic] : args.in[I_CRE][ic]); }
        }
    }
#if !MK_SLABQ
    SEAM(0);
#endif

    if (IN(1) && !MK_SLABQ) {
        FRESH_IDS();
        LAS unsigned* scr = (LAS unsigned*)(lds + wave * 16896);
        constexpr int I_Q = (DM / 128) * (2 * DFF / 128);
        constexpr int I_QM = (DM / 128) * (MIXC / 128 - 32);
        for (int it = gw; it < ((MK_I8_FFN & 1) ? I_Q : 0) + ((MK_I8_FFN & 2) ? I_Q : 0) + (MK_I8_MIX ? I_QM : 0); it += NGW) {
            int r = it;
            if (MK_I8_FFN & 1) { if (r < I_Q) { p0_item_i8(args.in[I_F1IN], args.in[I_F1N], DM, 2 * DFF, 1, (const unsigned*)(ctl + CW_COLMAX), (float*)(ws + WS_COLSC1), ws + WS_W1IN, scr, r, lane); continue; } r -= I_Q; }
            if (MK_I8_MIX) { if (r < I_QM) { p0_item_i8(args.in[I_MIXIN], args.in[I_MIXN], DM, MIXC, 2, (const unsigned*)(ctl + CW_COLMAX) + 4 * DFF, (float*)(ws + WS_COLSC3), ws + WS_WMIX, scr, r, lane, true); continue; } r -= I_QM; }
            if (MK_I8_FFN & 2) p0_item_i8(args.in[I_F2IN], args.in[I_F2N], DM, 2 * DFF, 1, (const unsigned*)(ctl + CW_COLMAX) + 2 * DFF, (float*)(ws + WS_COLSC2), ws + WS_W2IN, scr, r, lane);
        }
    }
    SEAM(1);

    if (IN(2)) {
        pg8::StaticOrder S; S.init(MTOK, 2 * DFF, G, bid); pg8::Unit u0;
#if MK_I8_FFN & 1
        if (S.next(0, u0) && threadIdx.x < 256) rstd_tab[threadIdx.x] = ((const float*)(ws + WS_ROWFAC))[u0.pm * 256 + threadIdx.x];
        __syncthreads();
        { pg8::AddrStd AD{(const char*)(ws + WS_XB8), (const char*)(ws + WS_W1IN), 256u * DM, 256u * DM};
          pg8::EpiSwigluI8 E{(bf16*)(big + BG_HID), DFF, rstd_tab, (const float*)(ws + WS_COLSC1)};
          pg8::gemm_phase<2>(lds, DM / 2, DM / 2, DM / 2, AD, S, E); }
#else
        if (S.next(0, u0)) rstd_table(stats, u0.pm, rstd_tab); else __syncthreads();
        { pg8::AddrStd AD{(const char*)xb, (const char*)(ws + WS_W1IN), 256u * DM * 2u, 256u * DM * 2u};
          pg8::EpiSwiglu E{(bf16*)(big + BG_HID), DFF, rstd_tab};
          pg8::gemm_phase(lds, DM, DM, DM, AD, S, E); }
#endif
        { const bool tail = (G == 256); pg8::StaticOrder S2; S2.init(MMEM, 2 * DM, tail ? 128 : G, tail ? bid - 128 : bid);
          if (!tail || bid >= 128) {
#if MK_SLABQ && MK_I8_KV
              pg8::AddrStd AD{(const char*)(ws + WS_MEMN), (const char*)(ws + WS_WK), 256u * DM, 256u * DM};
              pg8::EpiBf16I8 E{(bf16*)(ws + WS_KV), 2 * DM, (const float*)(ws + WS_ROWFACM), (const float*)(ws + WS_COLSC4)};
              pg8::gemm_phase<2>(lds, DM / 2, DM / 2, DM / 2, AD, S2, E); } }
#else
              pg8::AddrStd AD{(const char*)(ws + WS_MEMN), (const char*)(ws + WS_WK), 256u * DM * 2u, 256u * DM * 2u};
              pg8::EpiBf16 E{(bf16*)(ws + WS_KV), 2 * DM, nullptr, 1.0f};
              pg8::gemm_phase(lds, DM, DM, DM, AD, S2, E); } }
#endif
    }
    SEAM(2);

    if (IN(3)) {
        pg8::AddrStd AD{(const char*)(big + BG_HID), (const char*)(ws + WS_W1OUT), 256u * DFF * 2u, 256u * DFF * 2u};
        pg8::EpiRes<true, true, true, (MK_FP8_GATES != 0 && !MK_I8_MIX), false, false, (MK_XF32 != 0 && (MK_I8_FFN & 1) != 0)> E{nullptr, xb, stats, ws + WS_XB8, args.in[I_X]};
        if (G == 256) { pg8::PanelOrder S; S.init(MTOK, DM, G, bid); pg8::gemm_phase(lds, DFF, DFF, DFF, AD, S, E); }
        else { pg8::StaticOrder S; S.init(MTOK, DM, G, bid); pg8::gemm_phase(lds, DFF, DFF, DFF, AD, S, E); }
        { pg8::StaticOrder S2; S2.init(DM, DM, G, bid); pg8::AddrQK AD2{(const char*)(ws + WS_KV), (const char*)(ws + WS_WQ)};
#if MK_FP8_ATTN
          pg8::EpiFp8 E2{ws + WS_WQK, DM, 1.0f}; pg8::gemm_phase(lds, HD, 2 * DM, DM, AD2, S2, E2); }
#else
          pg8::EpiBf16 E2{(bf16*)(ws + WS_WQK), DM, nullptr, 1.0f}; pg8::gemm_phase(lds, HD, 2 * DM, DM, AD2, S2, E2); }
#endif
        { pg8::StaticOrder S3; S3.init(DM, DM, G, bid); pg8::AddrVO AD3{(const char*)(ws + WS_WO), (const char*)(ws + WS_KV)};
#if MK_FP8_ATTN
          pg8::EpiFp8 E3{ws + WS_WVO, DM, 1.0f}; pg8::gemm_phase(lds, HD, DM, 2 * DM, AD3, S3, E3); }
#else
          pg8::EpiBf16 E3{(bf16*)(ws + WS_WVO), DM, nullptr, 1.0f}; pg8::gemm_phase(lds, HD, DM, 2 * DM, AD3, S3, E3); }
#endif
    }
    SEAM(3);

    if (IN(4)) {
        FRESH_IDS();
        if (MK_I8_MIX) for (int m = gw; m < MTOK; m += NGW) row_quant_bf16_i8(xb + (size_t)m * DM, stats + (size_t)m * 64, ws + WS_XB8 + (size_t)m * DM, (float*)(ws + WS_ROWFAC) + m, lane);
    }
    SEAM(4);

    if (IN(5)) {
#if MK_I8_MIX
        pg8::StaticOrder S; S.init(MTOK, DM, G, bid); pg8::Unit u0; const bool has = S.next(0, u0);
        if (has) rstd_table(stats, u0.pm, rstd_tab); else __syncthreads();
        { pg8::AddrStd AD{(const char*)xb, (const char*)(ws + WS_WMIX + 64 * MiB), 256u * DM * 2u, 256u * DM * 2u};
          pg8::EpiZc E{(bf16*)(big + BG_ZC), rstd_tab};
          pg8::gemm_phase(lds, DM, DM, DM, AD, S, E); }
        __syncthreads();
        if (has && threadIdx.x < 256) rstd_tab[threadIdx.x] = ((const float*)(ws + WS_ROWFAC))[u0.pm * 256 + threadIdx.x];
        __syncthreads();
        { pg8::StaticOrder S2; S2.init(MTOK, MIXC - DM, G, bid);
          pg8::AddrMixI8 AD{(const char*)(ws + WS_XB8), (const char*)(ws + WS_WMIX), 256u * DM, 256u * DM};
          pg8::EpiMixI8 E{(bf16*)(big + BG_USSM), (bf16*)(big + BG_CB), (bf16*)(big + BG_GA), (bf16*)(big + BG_GB), rstd_tab, (const float*)(ws + WS_COLSC3)};
          pg8::gemm_phase<2>(lds, DM / 2, DM / 2, DM / 2, AD, S2, E); }
#elif MK_FP8_GATES
        pg8::StaticOrder S; S.init(MTOK, MIXC / 2, G, bid); pg8::Unit u0;
        if (S.next(0, u0)) rstd_table(stats, u0.pm, rstd_tab); else __syncthreads();
        { pg8::AddrStd AD{(const char*)xb, (const char*)(ws + WS_WMIX), 256u * DM * 2u, 256u * DM * 2u};
          pg8::EpiMix E{(bf16*)(big + BG_USSM), (bf16*)(big + BG_CB), (bf16*)(big + BG_ZC), (bf16*)(big + BG_GA), (bf16*)(big + BG_GB), rstd_tab};
          pg8::gemm_phase(lds, DM, DM, DM, AD, S, E); }
        { pg8::AddrStd AD{(const char*)(ws + WS_XB8), (const char*)(ws + WS_WMIX8), 256u * DM, 256u * DM};
          pg8::EpiGate8 E{(bf16*)(big + BG_GA), (bf16*)(big + BG_GB), rstd_tab};
          pg8::gemm_phase<1>(lds, DM / 2, DM / 2, DM / 2, AD, S, E); }
#else
        pg8::StaticOrder S; S.init(MTOK, MIXC, G, bid); pg8::Unit u0;
        if (S.next(0, u0)) rstd_table(stats, u0.pm, rstd_tab); else __syncthreads();
        pg8::AddrStd AD{(const char*)xb, (const char*)(ws + WS_WMIX), 256u * DM * 2u, 256u * DM * 2u};
        pg8::EpiMix E{(bf16*)(big + BG_USSM), (bf16*)(big + BG_CB), (bf16*)(big + BG_ZC), (bf16*)(big + BG_GA), (bf16*)(big + BG_GB), rstd_tab};
        pg8::gemm_phase(lds, DM, DM, DM, AD, S, E);
#endif
    }

    SEAM(5);

    if (IN(6)) {
        FRESH_IDS();
        const bf16* ussm = (const bf16*)(big + BG_USSM);
        constexpr int NA = NB * NG * (SSM_NSEG - 1);
        if (gw < NA) { const int g = gw & 127, bs = gw >> 7;
            ssm_unit<false>(lds + wave * 12800, ws, ussm, (bf16*)(ws + WS_YS), args.in[I_SSMD], bs / (SSM_NSEG - 1), g, bs % (SSM_NSEG - 1), lane); }
        {
            const bool split = NGW > NA;
            const int cw = split ? gw - NA : gw, ncw = split ? NGW - NA : NGW;
            if (cw >= 0) {
                const bf16* zc = (const bf16*)(big + BG_ZC); const bf16* cbp = (const bf16*)(big + BG_CB); bf16* ycv = (bf16*)(ws + WS_YCV);
                for (int cu = cw; cu < (MTOK / 64) * 4; cu += ncw) {
                    const int seg = cu >> 2, ch0 = (cu & 3) * 512 + lane * 8, t0 = seg * 64;
                    float w0[8], w1[8], w2[8];
#pragma unroll
                    for (int j = 0; j < 8; ++j) { w0[j] = args.in[I_CONVW][ch0 + j]; w1[j] = args.in[I_CONVW][DCONV + ch0 + j]; w2[j] = args.in[I_CONVW][2 * DCONV + ch0 + j]; }
                    u32x4 z2 = {0u, 0u, 0u, 0u}, z1 = {0u, 0u, 0u, 0u};
                    if ((t0 & (SEQ - 1)) != 0) { z2 = *(const GAS u32x4*)(zc + (size_t)(t0 - 2) * DCONV + ch0); z1 = *(const GAS u32x4*)(zc + (size_t)(t0 - 1) * DCONV + ch0); }
#pragma unroll 4
                    for (int t = t0; t < t0 + 64; ++t) {
                        const u32x4 z0 = *(const GAS u32x4*)(zc + (size_t)t * DCONV + ch0), cbv = *(const GAS u32x4*)(cbp + (size_t)t * DCONV + ch0);
                        const unsigned a2[4] = {z2.x, z2.y, z2.z, z2.w}, a1[4] = {z1.x, z1.y, z1.z, z1.w}, a0[4] = {z0.x, z0.y, z0.z, z0.w}, cc[4] = {cbv.x, cbv.y, cbv.z, cbv.w}; unsigned ow[4];
#pragma unroll
                        for (int h = 0; h < 4; ++h) {
                            const float e = bf_lo(cc[h]) * (w0[2 * h] * bf_lo(a2[h]) + w1[2 * h] * bf_lo(a1[h]) + w2[2 * h] * bf_lo(a0[h]));
                            const float o = bf_hi(cc[h]) * (w0[2 * h + 1] * bf_hi(a2[h]) + w1[2 * h + 1] * bf_hi(a1[h]) + w2[2 * h + 1] * bf_hi(a0[h]));
                            ow[h] = pk2(e, o); }
                        u32x4 w; w.x = ow[0]; w.y = ow[1]; w.z = ow[2]; w.w = ow[3];
                        *(GAS u32x4*)(ycv + (size_t)t * DCONV + ch0) = w;
                        z2 = z1; z1 = z0;
                    }
                }
            }
        }
    }
    SEAM(6);

    if (IN(7)) {
        FRESH_IDS();
        const bf16* ussm = (const bf16*)(big + BG_USSM);
        for (int un = gw; un < NB * NG * SSM_NSEG; un += NGW) { const int g = un & 127, bs = un >> 7;
            ssm_unit<true>(lds + wave * 12800, ws, ussm, (bf16*)(ws + WS_YS), args.in[I_SSMD], bs / SSM_NSEG, g, bs % SSM_NSEG, lane); }
    }
    SEAM(7);

    if (IN(8)) {
        pg8::StaticOrder S; S.init(MTOK, DM, G, bid);
        pg8::AddrStd AD{(const char*)(ws + WS_YCV), (const char*)(ws + WS_WCOUT), 256u * DCONV * 2u, 256u * DCONV * 2u};
        pg8::EpiConvOut E{(const bf16*)(big + BG_GB), (bf16*)(big + BG_TMP)};
        pg8::gemm_phase(lds, DCONV, DCONV, DCONV, AD, S, E);
    }
    SEAM(8);

    if (IN(9)) {
        pg8::StaticOrder S; S.init(MTOK, 2 * DM, G, bid);
        pg8::AddrStd AD{(const char*)(ws + WS_YS), (const char*)(ws + WS_WGLU), 256u * DSSM * 2u, 256u * DSSM * 2u};
        pg8::EpiGlu E{(const bf16*)(big + BG_GA), (bf16*)(big + BG_TMP)};
        pg8::gemm_phase(lds, DSSM, DSSM, DSSM, AD, S, E);
    }
    SEAM(9);

    if (IN(10)) {
        pg8::StaticOrder S; S.init(MTOK, DM, G, bid);
        pg8::AddrStd AD{(const char*)(big + BG_TMP), (const char*)(ws + WS_WMO), 256u * DM * 2u, 256u * DM * 2u};
        pg8::EpiRes<true, true, false, MK_FP8_ATTN != 0> E{nullptr, xb, stats, ws + WS_XB8};
        pg8::gemm_phase(lds, DM, DM, DM, AD, S, E);
    }
    SEAM(10);

    if (IN(11)) {
        pg8::StaticOrder S; S.init(MTOK, NH * NMEM, G, bid); pg8::Unit u0;
        if (S.next(0, u0)) rstd_table(stats, u0.pm, rstd_tab); else __syncthreads();
#if MK_FP8_ATTN
        pg8::AddrSc8 AD{(const char*)(ws + WS_XB8), (const char*)(ws + WS_WQK)};
        pg8::EpiSoftmax<true> E{(bf16*)(big + BG_P), rstd_tab, (LAS float*)(lds + XCH_OFF), 0.03125f * 1.4426950408889634f};
        pg8::gemm_phase<1>(lds, DM / 2, DM / 2, DM / 2, AD, S, E);
#else
        pg8::AddrSc AD{(const char*)xb, (const char*)(ws + WS_WQK)};
        pg8::EpiSoftmax<false> E{(bf16*)(big + BG_P), rstd_tab, (LAS float*)(lds + XCH_OFF), 0.03125f * 1.4426950408889634f};
        pg8::gemm_phase(lds, DM, DM, DM, AD, S, E);
#endif
    }
    SEAM(11);

    if (IN(12)) {
        pg8::StaticOrder S; S.init(MTOK, DM, G, bid);
#if MK_FP8_ATTN
        pg8::AddrAO8 AD{(const char*)(big + BG_P), (const char*)(ws + WS_WVO)};
        pg8::EpiRes<true, true, false, false, false, true> E{nullptr, xb, stats, nullptr};
        pg8::gemm_phase<1>(lds, NH * NMEM / 2, NH * NMEM / 2, DM / 2, AD, S, E);
#else
        pg8::AddrAO AD{(const char*)(big + BG_P), (const char*)(ws + WS_WVO)};
        pg8::EpiRes<true, true, false> E{nullptr, xb, stats, nullptr};
        pg8::gemm_phase(lds, NH * NMEM, NH * NMEM, DM, AD, S, E);
#endif
    }
    SEAM(12);

    if (IN(13)) {
        FRESH_IDS();
        if (MK_I8_FFN & 2) for (int m = gw; m < MTOK; m += NGW) row_quant_bf16_i8(xb + (size_t)m * DM, stats + (size_t)m * 64, ws + WS_XB8 + (size_t)m * DM, (float*)(ws + WS_ROWFAC) + m, lane);
    }
    SEAM(13);

    if (IN(14)) {
        pg8::StaticOrder S; S.init(MTOK, 2 * DFF, G, bid); pg8::Unit u0;
#if MK_I8_FFN & 2
        if (S.next(0, u0) && threadIdx.x < 256) rstd_tab[threadIdx.x] = ((const float*)(ws + WS_ROWFAC))[u0.pm * 256 + threadIdx.x];
        __syncthreads();
        pg8::AddrStd AD{(const char*)(ws + WS_XB8), (const char*)(ws + WS_W2IN), 256u * DM, 256u * DM};
        pg8::EpiSwigluI8 E{(bf16*)(big + BG_HID), DFF, rstd_tab, (const float*)(ws + WS_COLSC2)};
        pg8::gemm_phase<2>(lds, DM / 2, DM / 2, DM / 2, AD, S, E);
#else
        if (S.next(0, u0)) rstd_table(stats, u0.pm, rstd_tab); else __syncthreads();
        pg8::AddrStd AD{(const char*)xb, (const char*)(ws + WS_W2IN), 256u * DM * 2u, 256u * DM * 2u};
        pg8::EpiSwiglu E{(bf16*)(big + BG_HID), DFF, rstd_tab};
        pg8::gemm_phase(lds, DM, DM, DM, AD, S, E);
#endif
    }
    SEAM(14);

    if (IN(15)) {
        pg8::AddrStd AD{(const char*)(big + BG_HID), (const char*)(ws + WS_W2OUT), 256u * DFF * 2u, 256u * DFF * 2u};
        pg8::EpiRes<true, false, true> E{nullptr, xb, nullptr, nullptr};
        if (G == 256) { pg8::PanelOrder S; S.init(MTOK, DM, G, bid); pg8::gemm_phase(lds, DFF, DFF, DFF, AD, S, E); }
        else { pg8::StaticOrder S; S.init(MTOK, DM, G, bid); pg8::gemm_phase(lds, DFF, DFF, DFF, AD, S, E); }
    }
    SEAM(15);

    if (IN(16)) {
        FRESH_IDS();
        const float* gf = args.in[I_FINN];
        for (int m = gw; m < MTOK; m += NGW) {
            const GAS u32x2* xr = (const GAS u32x2*)(xb + (size_t)m * DM) + lane; GAS f32x4* orow = (GAS f32x4*)(hres + (size_t)m * DM) + lane;
            f32x4 v[16]; float s = 0.f;
#pragma unroll
            for (int j = 0; j < 16; ++j) { const u32x2 w = xr[64 * j]; v[j] = (f32x4){bf_lo(w.x), bf_hi(w.x), bf_lo(w.y), bf_hi(w.y)}; s += (v[j].x * v[j].x + v[j].y * v[j].y) + (v[j].z * v[j].z + v[j].w * v[j].w); }
            const float sc = 1.0f / sqrtf(wave_sum(s) * (1.0f / DM) + RMS_EPS);
#pragma unroll
            for (int j = 0; j < 16; ++j) { const f32x4 g = ((const GAS f32x4*)gf)[lane + 64 * j]; orow[64 * j] = v[j] * sc * g; }
        }
    }
#undef IN
#undef SEAM
}

extern "C" void kernel_launch(void* const* d_in, const int* in_sizes, int n_in, void* d_out, int out_size, void* d_ws, size_t ws_size, hipStream_t stream) {
    static int grid = 0;
    if (grid == 0) {
        if (n_in != 29 || in_sizes[0] != MTOK * DM || out_size != MTOK * DM || ws_size < WS_END) {
            fprintf(stderr, "kernel_launch: unexpected shapes / workspace (n_in %d, in0 %d, out %d, ws %zu, need %zu)\n", n_in, n_in > 0 ? in_sizes[0] : -1, out_size, ws_size, (size_t)WS_END); grid = -1; return; }
        int dev = 0, cus = 0, per_cu = 0;
        if (hipGetDevice(&dev) != hipSuccess || hipDeviceGetAttribute(&cus, hipDeviceAttributeMultiprocessorCount, dev) != hipSuccess) { grid = -1; return; }
        if (hipFuncSetAttribute((const void*)mk_fwd, hipFuncAttributeMaxDynamicSharedMemorySize, LDS_BYTES) != hipSuccess) { grid = -1; return; }
        if (hipOccupancyMaxActiveBlocksPerMultiprocessor(&per_cu, (const void*)mk_fwd, NWAVES * 64, LDS_BYTES) != hipSuccess || per_cu < 1)
            fprintf(stderr, "kernel_launch: occupancy query reports %d workgroups per CU\n", per_cu);
        (void)hipGetLastError();
        grid = cus;
    }
    if (grid < 0) return;
    if (hipMemsetAsync((char*)d_ws + WS_CTL, 0, CTL_ZERO_BYTES, stream) != hipSuccess) return;
    Args a{};
    for (int i = 0; i < 29; ++i) a.in[i] = (const float*)d_in[i];
    a.out = (float*)d_out; a.ws = (unsigned char*)d_ws;
#if MK_ONE_LAUNCH
    a.ph_lo = 0; a.ph_hi = NPHASE;
    hipLaunchKernelGGL(mk_fwd, dim3(grid), dim3(NWAVES * 64), LDS_BYTES, stream, a);
#else
    for (int p = 0; p < NPHASE; ++p) { a.ph_lo = p; a.ph_hi = p + 1; hipLaunchKernelGGL(mk_fwd, dim3(grid), dim3(NWAVES * 64), LDS_BYTES, stream, a); }
#endif
}
```

```cpp
#include <hip/hip_runtime.h>
#include <cstdio>
#include <cstdint>

#ifndef MK_ONE_LAUNCH
#define MK_ONE_LAUNCH 1
#endif
#ifndef MK_I8_FFN
#define MK_I8_FFN 3
#endif
#ifndef MK_I8_MIX
#define MK_I8_MIX 1
#endif
#ifndef MK_SLABQ
#define MK_SLABQ 1
#endif
#ifndef MK_I8_KV
#define MK_I8_KV 1
#endif
#ifndef MK_XF32
#define MK_XF32 1
#endif
#ifndef MK_FP8_ATTN
#define MK_FP8_ATTN 1
#endif
#ifndef MK_FP8_GATES
#define MK_FP8_GATES 1
#endif

#define GAS __attribute__((address_space(1)))
#define LAS __attribute__((address_space(3)))
typedef unsigned short bf16;
typedef short bf16x8 __attribute__((ext_vector_type(8)));
typedef float f32x4 __attribute__((ext_vector_type(4)));
typedef float f32x2 __attribute__((ext_vector_type(2)));
typedef unsigned u32x4 __attribute__((ext_vector_type(4)));
typedef unsigned u32x2 __attribute__((ext_vector_type(2)));
typedef GAS unsigned gu32;
typedef int v8i __attribute__((ext_vector_type(8)));
typedef int v4i __attribute__((ext_vector_type(4)));

constexpr int DM = 4096, NB = 4, SEQ = 4096, MTOK = NB * SEQ, DFF = 11008, DSSM = 2048, DCONV = 2048, NMEM = 256, MMEM = NB * NMEM, NH = 4, HD = 1024;
constexpr int NG = 128, GH = 16, GP = 64, MIXC = 16384;
constexpr float RMS_EPS = 1e-6f;
constexpr int NWAVES = 8;

constexpr size_t MiB = 1u << 20;
constexpr size_t WS_CTL = 0, CTL_ZERO_BYTES = 1 * MiB;
constexpr size_t WS_STATS = 1 * MiB;
constexpr size_t WS_W1IN = 5 * MiB;
constexpr size_t WS_W1OUT = WS_W1IN + 172 * MiB;
constexpr size_t WS_WMIX = WS_W1OUT + 86 * MiB;
constexpr size_t WS_WGLU = WS_WMIX + 128 * MiB;
constexpr size_t WS_WCOUT = WS_WGLU + 32 * MiB;
constexpr size_t WS_WMO = WS_WCOUT + 16 * MiB;
constexpr size_t WS_WQ = WS_WMO + 32 * MiB;
constexpr size_t WS_WK = WS_WQ + 32 * MiB;
constexpr size_t WS_WV = WS_WK + 32 * MiB;
constexpr size_t WS_WO = WS_WV + 32 * MiB;
constexpr size_t WS_W2IN = WS_WO + 32 * MiB;
constexpr size_t WS_W2OUT = WS_W2IN + 172 * MiB;
constexpr size_t WS_XB = WS_W2OUT + 86 * MiB;
constexpr size_t WS_BIG = WS_XB + 128 * MiB;
constexpr size_t WS_YS = WS_BIG + 448 * MiB;
constexpr size_t WS_YCV = WS_YS + 64 * MiB;
constexpr size_t WS_MEMN = WS_YCV + 64 * MiB;
constexpr size_t WS_KV = WS_MEMN + 8 * MiB;
constexpr size_t WS_SSMC = WS_KV + 16 * MiB;
constexpr size_t WS_WQK = WS_SSMC + 2 * MiB;
constexpr size_t WS_WVO = WS_WQK + 32 * MiB;
constexpr size_t WS_ESEG = WS_WVO + 32 * MiB;
constexpr size_t WS_XB8 = WS_ESEG + 1 * MiB;
constexpr size_t WS_END = WS_XB8 + 64 * MiB;
constexpr size_t WS_WMIX8 = WS_WMIX + (size_t)8192 * DM * 2;
constexpr size_t BG_HID = 0;
constexpr size_t BG_USSM = 0, BG_CB = 64 * MiB, BG_ZC = 128 * MiB, BG_GA = 192 * MiB, BG_GB = 320 * MiB;
constexpr size_t BG_TMP = 0;
constexpr size_t BG_P = 128 * MiB;

constexpr int CW_BAR = 4096;
constexpr int CW_COLMAX = 8192;
constexpr size_t WS_ROWFAC = WS_SSMC + 1664 * 1024;
constexpr size_t WS_COLSC1 = WS_SSMC + 1728 * 1024;
constexpr size_t WS_COLSC2 = WS_SSMC + 1816 * 1024;
constexpr size_t WS_COLSC4 = WS_SSMC + 1968 * 1024;
constexpr size_t WS_ROWFACM = WS_SSMC + 2000 * 1024;
constexpr size_t WS_COLSC3 = WS_SSMC + 1904 * 1024;

constexpr int RING_BYTES = 131072;
constexpr int XCH_OFF = 131072;
constexpr int RSTD_OFF = 143360;
constexpr int MISC_OFF = 144384;
constexpr int LDS_BYTES = 147456;

#define LDS_WAIT() asm volatile("s_waitcnt lgkmcnt(0)" ::: "memory")
#define VM_WAIT() asm volatile("s_waitcnt vmcnt(0)" ::: "memory")

__device__ __forceinline__ unsigned f2bf(float f) { unsigned u = __builtin_bit_cast(unsigned, f); return (u + 0x7fffu + ((u >> 16) & 1u)) >> 16; }
__device__ __forceinline__ unsigned pk2(float lo, float hi) { return f2bf(lo) | (f2bf(hi) << 16); }
typedef __bf16 bf16x2_t __attribute__((ext_vector_type(2)));
__device__ __forceinline__ unsigned cvt_pk_bf16(float lo, float hi) { const f32x2 v = {lo, hi}; const bf16x2_t b = __builtin_convertvector(v, bf16x2_t); return __builtin_bit_cast(unsigned, b); }
__device__ __forceinline__ float bf_lo(unsigned w) { return __builtin_bit_cast(float, w << 16); }
__device__ __forceinline__ float bf_hi(unsigned w) { return __builtin_bit_cast(float, w & 0xffff0000u); }
__device__ __forceinline__ float sigmoidf_(float x) { return __builtin_amdgcn_rcpf(1.0f + __builtin_amdgcn_exp2f(-1.4426950408889634f * x)); }
__device__ __forceinline__ float wave_sum(float v) {
#pragma unroll
    for (int o = 1; o < 64; o <<= 1) v += __shfl_xor(v, o);
    return v;
}
__device__ __forceinline__ float wave_max(float v) {
#pragma unroll
    for (int o = 1; o < 64; o <<= 1) v = fmaxf(v, __shfl_xor(v, o));
    return v;
}
__device__ __forceinline__ float gelu1(float v) {
    const float av = fabsf(v), d = av * 0.2316418882f + 1.0f;
    const float t = __builtin_amdgcn_rcpf(d);
    float q = t * 0.5307027145f + (-0.7265760135f); q = q * t + 0.7107068705f; q = q * t + (-0.142248368f); q = q * t + 0.127414796f; q = q * t;
    const float e = __builtin_amdgcn_exp2f((v * v) * (-0.72134752044f));
    const float m = v * (q * e), r = v - m;
    return v < 0.f ? m : r;
}

namespace pg8 {
constexpr int BM = 256, BK = 64, HALF = 128, HTB = HALF * BK * 2, STAGE_BYTES = 8 * HTB, NXCD = 8, WGM = 8;
__host__ __device__ __forceinline__ int lds_byte(int r, int c) { const int st = (r >> 4) * 2 + (c >> 5), rr = r & 15, cc = c & 31, ob = rr * 64 + cc * 2; return st * 1024 + (ob ^ (((ob >> 9) & 1) << 5)); }
__host__ __device__ __forceinline__ void stage_rc(int b, int& R, int& C) { const int st = b / 1024, sb = b % 1024, swz = sb ^ (((sb >> 9) & 1) << 5); R = (st >> 1) * 16 + swz / 64; C = (st & 1) * 32 + (swz % 64) / 2; }
__host__ __device__ __forceinline__ int perm32(int rho) { const int n = rho >> 4, i = rho & 15; return 8 * (i >> 2) + 4 * n + (i & 3); }

struct Unit { int pm, pn; };
struct StaticOrder {
    int nM, nN, nwg, G, c;
    __host__ __device__ __forceinline__ void init(int M, int N, int G_, int c_) { nM = M / BM; nN = N / BM; nwg = nM * nN; G = G_; c = c_; }
    __host__ __device__ __forceinline__ bool next(int i, Unit& u) const {
        const long L = (long)i * G + c; if (L >= nwg) return false;
        int wgid = (int)L; { const int q = nwg / NXCD, r = nwg % NXCD, xcd = wgid % NXCD, off = wgid / NXCD; wgid = (xcd < r ? xcd * (q + 1) : r * (q + 1) + (xcd - r) * q) + off; }
        const int nig = WGM * nN, gid = wgid / nig, fm = gid * WGM, gsz = (nM - fm) < WGM ? (nM - fm) : WGM;
        u.pm = fm + ((wgid % nig) % gsz); u.pn = (wgid % nig) / gsz; return true;
    }
};
struct PanelOrder {
    int nM, G, c;
    __host__ __device__ __forceinline__ void init(int M, int N, int G_, int c_) { nM = M / BM; G = G_; c = c_; (void)N; }
    __host__ __device__ __forceinline__ bool next(int i, Unit& u) const {
        if (16 * i >= nM) return false;
        const int x = c & 7, j = c >> 3;
        u.pm = 16 * i + 8 * (x & 1) + (j & 7); u.pn = 4 * (x >> 1) + (j >> 3); return true;
    }
};
struct AddrStd { const char* A; const char* B; unsigned ta, tb;
    __device__ __forceinline__ const char* abase() const { return A; } __device__ __forceinline__ const char* bbase() const { return B; }
    __device__ __forceinline__ unsigned a(const Unit& u) const { return (unsigned)u.pm * ta; }
    __device__ __forceinline__ unsigned b(const Unit& u) const { return (unsigned)u.pn * tb; } };
struct AddrMixI8 { const char* A; const char* B; unsigned ta, tb;
    __device__ __forceinline__ const char* abase() const { return A; } __device__ __forceinline__ const char* bbase() const { return B; }
    __device__ __forceinline__ unsigned a(const Unit& u) const { return (unsigned)u.pm * ta; }
    __device__ __forceinline__ unsigned b(const Unit& u) const { return (unsigned)(u.pn + (u.pn >= 16 ? 16 : 0)) * tb; } };
struct AddrQK {
    const char* KV; const char* WqN;
    __device__ __forceinline__ const char* abase() const { return KV; } __device__ __forceinline__ const char* bbase() const { return WqN; }
    __device__ __forceinline__ unsigned a(const Unit& u) const { return ((unsigned)(u.pm >> 2) * NMEM * (2 * DM) + (unsigned)(u.pm & 3) * HD) * 2u; }
    __device__ __forceinline__ unsigned b(const Unit& u) const { return ((unsigned)u.pn * 256 * DM + (unsigned)(u.pm & 3) * HD) * 2u; } };
struct AddrVO {
    const char* WoT; const char* KV;
    __device__ __forceinline__ const char* abase() const { return WoT; } __device__ __forceinline__ const char* bbase() const { return KV; }
    __device__ __forceinline__ unsigned a(const Unit& u) const { return ((unsigned)u.pm * 256 * DM + (unsigned)(u.pn & 3) * HD) * 2u; }
    __device__ __forceinline__ unsigned b(const Unit& u) const { return ((unsigned)(u.pn >> 2) * NMEM * (2 * DM) + DM + (unsigned)(u.pn & 3) * HD) * 2u; } };
struct AddrSc {
    const char* X; const char* Wqk;
    __device__ __forceinline__ const char* abase() const { return X; } __device__ __forceinline__ const char* bbase() const { return Wqk; }
    __device__ __forceinline__ unsigned a(const Unit& u) const { return (unsigned)u.pm * 256 * DM * 2u; }
    __device__ __forceinline__ unsigned b(const Unit& u) const { return ((unsigned)(u.pm >> 4) * 1024 + (unsigned)u.pn * 256) * DM * 2u; } };
struct AddrAO {
    const char* P; const char* Wvo;
    __device__ __forceinline__ const char* abase() const { return P; } __device__ __forceinline__ const char* bbase() const { return Wvo; }
    __device__ __forceinline__ unsigned a(const Unit& u) const { return (unsigned)u.pm * 256 * 1024 * 2u; }
    __device__ __forceinline__ unsigned b(const Unit& u) const { return ((unsigned)u.pn * 256 * DM + (unsigned)(u.pm >> 4) * 1024) * 2u; } };

struct AddrSc8 {
    const char* X; const char* Wqk;
    __device__ __forceinline__ const char* abase() const { return X; } __device__ __forceinline__ const char* bbase() const { return Wqk; }
    __device__ __forceinline__ unsigned a(const Unit& u) const { return (unsigned)u.pm * 256 * DM; }
    __device__ __forceinline__ unsigned b(const Unit& u) const { return ((unsigned)(u.pm >> 4) * 1024 + (unsigned)u.pn * 256) * DM; } };
struct AddrAO8 {
    const char* P; const char* Wvo;
    __device__ __forceinline__ const char* abase() const { return P; } __device__ __forceinline__ const char* bbase() const { return Wvo; }
    __device__ __forceinline__ unsigned a(const Unit& u) const { return (unsigned)u.pm * 256 * 1024; }
    __device__ __forceinline__ unsigned b(const Unit& u) const { return (unsigned)u.pn * 256 * DM + (unsigned)(u.pm >> 4) * 1024; } };
typedef f32x4 Acc[2][2][4][2];

template <int MODE = 0  , class Epi, class Sched, class Addr>
__device__ __forceinline__ void gemm_phase(LAS unsigned char* lds, const int K, const int lda, const int ldb, const Addr& AD, const Sched& S, const Epi& E) {
    const int tid = threadIdx.x, wid = __builtin_amdgcn_readfirstlane(tid >> 6), lane = tid & 63, wr = wid >> 2, wc = wid & 3, fr = lane & 15, fq = lane >> 4;
    int nt = K / BK; asm volatile("" : "+s"(nt));
    unsigned voffA, voffB;
    { int R, C; stage_rc(tid * 16, R, C); const int Rb = (R & ~31) + perm32(R & 31); voffA = (unsigned)(R * lda + C) * 2u; voffB = (unsigned)(Rb * ldb + C) * 2u; }
    const unsigned pstepA = 64u * (unsigned)lda * 2u, pstepB = 64u * (unsigned)ldb * 2u;
    const unsigned kstep = (unsigned)(BK * 2);
    const unsigned hstepA = (unsigned)HALF * lda * 2u, hstepB = (unsigned)HALF * ldb * 2u;
    const __amdgpu_buffer_rsrc_t rA = __builtin_amdgcn_make_buffer_rsrc((void*)AD.abase(), 0, (int)0xffffffffu, 0x00020000);
    const __amdgpu_buffer_rsrc_t rB = __builtin_amdgcn_make_buffer_rsrc((void*)AD.bbase(), 0, (int)0xffffffffu, 0x00020000);
    const unsigned ldsw = (unsigned)wid * 1024u;
    const int aoff = lds_byte(wr * 64 + fr, fq * 8), boff = lds_byte(wc * 32 + fr, fq * 8);
#define PG8_SA(b, h) (((b) * 2 + (h)) * HTB)
#define PG8_SB(b, h) ((4 + (b) * 2 + (h)) * HTB)
#define PG8_STAGE(bufoff, rs, soff, voff) do { _Pragma("unroll") for (int _i = 0; _i < 2; ++_i) \
        __builtin_amdgcn_raw_ptr_buffer_load_lds(rs, (LAS void*)(lds + (bufoff) + ldsw + _i * 8192), 16, (voff), (soff) + _i * p##voff, 0, 0); } while (0)
#define pvoffA pstepA
#define pvoffB pstepB
#define PG8_LDA(dst, b, h) do { _Pragma("unroll") for (int m = 0; m < 4; ++m) { const v4i _l = *(const LAS v4i*)(lds + PG8_SA(b, h) + aoff + m * 2048), _h = *(const LAS v4i*)(lds + PG8_SA(b, h) + aoff + m * 2048 + 1024); \
        dst[m] = __builtin_shufflevector(_l, _h, 0, 1, 2, 3, 4, 5, 6, 7); } } while (0)
#define PG8_LDB(dst, b, h) do { _Pragma("unroll") for (int n = 0; n < 2; ++n) { const v4i _l = *(const LAS v4i*)(lds + PG8_SB(b, h) + boff + n * 2048), _h = *(const LAS v4i*)(lds + PG8_SB(b, h) + boff + n * 2048 + 1024); \
        dst[n] = __builtin_shufflevector(_l, _h, 0, 1, 2, 3, 4, 5, 6, 7); } } while (0)
#define PG8_LO(v) __builtin_bit_cast(bf16x8, __builtin_shufflevector(v, v, 0, 1, 2, 3))
#define PG8_HI(v) __builtin_bit_cast(bf16x8, __builtin_shufflevector(v, v, 4, 5, 6, 7))
#define PG8_LO4(v) __builtin_shufflevector(v, v, 0, 1, 2, 3)
#define PG8_HI4(v) __builtin_shufflevector(v, v, 4, 5, 6, 7)
#define PG8_MMA(ai, bj, At, Bt) do { __builtin_amdgcn_s_setprio(1); _Pragma("unroll") for (int m = 0; m < 4; ++m) _Pragma("unroll") for (int n = 0; n < 2; ++n) { \
        if constexpr (MODE == 1) acc[ai][bj][m][n] = __builtin_amdgcn_mfma_scale_f32_16x16x128_f8f6f4(Bt[n], At[m], acc[ai][bj][m][n], 0, 0, 0, 0, 0, 0); \
        else if constexpr (MODE == 2) { v4i _c = __builtin_bit_cast(v4i, acc[ai][bj][m][n]); \
               _c = __builtin_amdgcn_mfma_i32_16x16x64_i8(PG8_LO4(Bt[n]), PG8_LO4(At[m]), _c, 0, 0, 0); _c = __builtin_amdgcn_mfma_i32_16x16x64_i8(PG8_HI4(Bt[n]), PG8_HI4(At[m]), _c, 0, 0, 0); \
               acc[ai][bj][m][n] = __builtin_bit_cast(f32x4, _c); } \
        else { acc[ai][bj][m][n] = __builtin_amdgcn_mfma_f32_16x16x32_bf16(PG8_LO(Bt[n]), PG8_LO(At[m]), acc[ai][bj][m][n], 0, 0, 0); \
               acc[ai][bj][m][n] = __builtin_amdgcn_mfma_f32_16x16x32_bf16(PG8_HI(Bt[n]), PG8_HI(At[m]), acc[ai][bj][m][n], 0, 0, 0); } } \
        __builtin_amdgcn_s_setprio(0); } while (0)
#define PG8_WAIT_V(n) asm volatile("s_waitcnt vmcnt(" #n ")" ::: "memory")
#define PG8_WAIT_L(n) asm volatile("s_waitcnt lgkmcnt(" #n ")" ::: "memory")
#define PG8_BAR __builtin_amdgcn_s_barrier()
#define PG8_SCHED __builtin_amdgcn_sched_barrier(0)
    Unit cur, nxt; int ui = 0;
    if (!S.next(0, cur)) return;
    Acc acc;
#pragma unroll
    for (int a = 0; a < 2; ++a)
#pragma unroll
        for (int b = 0; b < 2; ++b)
#pragma unroll
            for (int m = 0; m < 4; ++m)
#pragma unroll
                for (int n = 0; n < 2; ++n) acc[a][b][m][n] = (f32x4){0.f, 0.f, 0.f, 0.f};
    v8i At[4], B0[2], B1[2];
    unsigned cA = AD.a(cur), cB = AD.b(cur);
    PG8_STAGE(PG8_SB(0, 0), rB, cB, voffB); PG8_STAGE(PG8_SB(0, 1), rB, cB + hstepB, voffB); PG8_STAGE(PG8_SA(0, 0), rA, cA, voffA); PG8_STAGE(PG8_SA(0, 1), rA, cA + hstepA, voffA);
    if (wr == 1) PG8_BAR;
    PG8_WAIT_V(2); PG8_BAR;
    PG8_STAGE(PG8_SB(1, 0), rB, cB + kstep, voffB); PG8_STAGE(PG8_SA(1, 0), rA, cA + kstep, voffA); PG8_STAGE(PG8_SB(1, 1), rB, cB + hstepB + kstep, voffB);
    PG8_WAIT_V(6); PG8_BAR;
    for (;;) {
        const bool has_next = S.next(ui + 1, nxt);
        const unsigned nA = has_next ? AD.a(nxt) : cA, nB = has_next ? AD.b(nxt) : cB;
        for (int t = 0; t < nt; t += 2) {
            const bool last = (t == nt - 2);
            const unsigned a1 = cA + (unsigned)(t + 1) * kstep;
            const unsigned a2 = last ? nA : cA + (unsigned)(t + 2) * kstep, b2 = last ? nB : cB + (unsigned)(t + 2) * kstep;
            const unsigned a3 = a2 + kstep, b3 = b2 + kstep;
            PG8_LDB(B0, 0, 0); PG8_LDB(B1, 0, 1); PG8_SCHED; PG8_LDA(At, 0, 0); PG8_STAGE(PG8_SA(1, 1), rA, a1 + hstepA, voffA);
            PG8_WAIT_V(8); PG8_WAIT_L(0); PG8_BAR; PG8_MMA(0, 0, At, B0); PG8_MMA(0, 1, At, B1); PG8_BAR; PG8_SCHED;
            PG8_LDA(At, 0, 1); PG8_STAGE(PG8_SB(0, 0), rB, b2, voffB); PG8_STAGE(PG8_SB(0, 1), rB, b2 + hstepB, voffB); PG8_STAGE(PG8_SA(0, 0), rA, a2, voffA);
            PG8_WAIT_V(8); PG8_WAIT_L(0); PG8_BAR; PG8_MMA(1, 0, At, B0); PG8_MMA(1, 1, At, B1); PG8_BAR; PG8_SCHED;
            PG8_LDB(B0, 1, 0); PG8_LDB(B1, 1, 1); PG8_SCHED; PG8_LDA(At, 1, 0); PG8_STAGE(PG8_SA(0, 1), rA, a2 + hstepA, voffA);
            PG8_WAIT_V(8); PG8_WAIT_L(0); PG8_BAR; PG8_MMA(0, 0, At, B0); PG8_MMA(0, 1, At, B1); PG8_BAR; PG8_SCHED;
            PG8_LDA(At, 1, 1); PG8_STAGE(PG8_SB(1, 0), rB, b3, voffB); PG8_STAGE(PG8_SB(1, 1), rB, b3 + hstepB, voffB); PG8_STAGE(PG8_SA(1, 0), rA, a3, voffA);
            PG8_WAIT_V(8); PG8_WAIT_L(0); PG8_BAR; PG8_MMA(1, 0, At, B0); PG8_MMA(1, 1, At, B1); PG8_BAR; PG8_SCHED;
        }
        if (wr == 0) PG8_BAR;
        { int tz = threadIdx.x; asm volatile("" : "+v"(tz));
          const int wid2 = __builtin_amdgcn_readfirstlane(tz >> 6), lane2 = tz & 63;
          E(acc, cur, wid2 >> 2, wid2 & 3, lane2 & 15, lane2 >> 4); }
        if (!has_next) break;
#pragma unroll
        for (int a = 0; a < 2; ++a)
#pragma unroll
            for (int b = 0; b < 2; ++b)
#pragma unroll
                for (int m = 0; m < 4; ++m)
#pragma unroll
                    for (int n = 0; n < 2; ++n) acc[a][b][m][n] = (f32x4){0.f, 0.f, 0.f, 0.f};
        cur = nxt; cA = nA; cB = nB; ++ui;
        if (wr == 1) PG8_BAR;
    }
    PG8_WAIT_V(0);
    PG8_BAR;
#undef PG8_SA
#undef PG8_SB
#undef PG8_STAGE
#undef pvoffA
#undef pvoffB
#undef PG8_LDA
#undef PG8_LDB
#undef PG8_MMA
#undef PG8_LO4
#undef PG8_HI4
#undef PG8_LO
#undef PG8_HI
#undef PG8_WAIT_V
#undef PG8_WAIT_L
#undef PG8_BAR
#undef PG8_SCHED
}

struct EpiBf16 {
    bf16* O; int ldc; const LAS float* rstd; float scale;
    __device__ __forceinline__ void operator()(const Acc& acc, const Unit& u, int wr, int wc, int fr, int fq) const {
        const int col0 = u.pn * BM + wc * 32 + 8 * fq;
#pragma unroll
        for (int ai = 0; ai < 2; ++ai)
#pragma unroll
            for (int m = 0; m < 4; ++m) { const int rl = ai * HALF + wr * 64 + m * 16 + fr; const float s = (rstd ? rstd[rl] : 1.0f) * scale;
                bf16* rowp = O + (size_t)(u.pm * BM + rl) * ldc + col0;
#pragma unroll
                for (int bj = 0; bj < 2; ++bj) { const f32x4 v0 = acc[ai][bj][m][0] * s, v1 = acc[ai][bj][m][1] * s;
                    u32x4 w; w.x = cvt_pk_bf16(v0[0], v0[1]); w.y = cvt_pk_bf16(v0[2], v0[3]); w.z = cvt_pk_bf16(v1[0], v1[1]); w.w = cvt_pk_bf16(v1[2], v1[3]);
                    *(u32x4*)(rowp + bj * HALF) = w; } }
    }
};
struct EpiBf16I8 {
    bf16* O; int ldc; const float* rowfac; const float* colsc;
    __device__ __forceinline__ void operator()(const Acc& acc, const Unit& u, int wr, int wc, int fr, int fq) const {
        const int col0 = u.pn * BM + wc * 32 + 8 * fq;
        f32x4 cs[2][2];
#pragma unroll
        for (int bj = 0; bj < 2; ++bj)
#pragma unroll
            for (int n = 0; n < 2; ++n) cs[bj][n] = *(const GAS f32x4*)(colsc + col0 + bj * HALF + 4 * n);
#pragma unroll
        for (int ai = 0; ai < 2; ++ai)
#pragma unroll
            for (int m = 0; m < 4; ++m) { const int r = u.pm * BM + ai * HALF + wr * 64 + m * 16 + fr; const float rf = ((const GAS float*)rowfac)[r];
                bf16* rowp = O + (size_t)r * ldc + col0;
#pragma unroll
                for (int bj = 0; bj < 2; ++bj) { const v4i i0 = __builtin_bit_cast(v4i, acc[ai][bj][m][0]), i1 = __builtin_bit_cast(v4i, acc[ai][bj][m][1]); f32x4 v0, v1;
#pragma unroll
                    for (int j = 0; j < 4; ++j) { v0[j] = (float)i0[j] * (rf * cs[bj][0][j]); v1[j] = (float)i1[j] * (rf * cs[bj][1][j]); }
                    u32x4 w; w.x = cvt_pk_bf16(v0[0], v0[1]); w.y = cvt_pk_bf16(v0[2], v0[3]); w.z = cvt_pk_bf16(v1[0], v1[1]); w.w = cvt_pk_bf16(v1[2], v1[3]);
                    *(u32x4*)(rowp + bj * HALF) = w; } }
    }
};
struct EpiFp8 {
    unsigned char* O; int ldc; float scale;
    __device__ __forceinline__ void operator()(const Acc& acc, const Unit& u, int wr, int wc, int fr, int fq) const {
        const int col0 = u.pn * BM + wc * 32 + 8 * fq;
#pragma unroll
        for (int ai = 0; ai < 2; ++ai)
#pragma unroll
            for (int m = 0; m < 4; ++m) { unsigned char* rowp = O + (size_t)(u.pm * BM + ai * HALF + wr * 64 + m * 16 + fr) * ldc + col0;
#pragma unroll
                for (int bj = 0; bj < 2; ++bj) { const f32x4 v0 = acc[ai][bj][m][0] * scale, v1 = acc[ai][bj][m][1] * scale; unsigned w0 = 0u, w1 = 0u;
                    w0 = __builtin_amdgcn_cvt_pk_fp8_f32(v0[0], v0[1], w0, false); w0 = __builtin_amdgcn_cvt_pk_fp8_f32(v0[2], v0[3], w0, true);
                    w1 = __builtin_amdgcn_cvt_pk_fp8_f32(v1[0], v1[1], w1, false); w1 = __builtin_amdgcn_cvt_pk_fp8_f32(v1[2], v1[3], w1, true);
                    u32x2 w; w.x = w0; w.y = w1; *(u32x2*)(rowp + bj * HALF) = w; } }
    }
};
template <bool P8> struct EpiSoftmax {
    bf16* P; const LAS float* rstd; LAS float* xch; float scale2;
    __device__ __forceinline__ void operator()(Acc& acc, const Unit& u, int wr, int wc, int fr, int fq) const {
        LAS float* xmax = xch; LAS float* xsum = xch + 1024;
#pragma unroll
        for (int ai = 0; ai < 2; ++ai)
#pragma unroll
            for (int m = 0; m < 4; ++m) { const int rl = ai * HALF + wr * 64 + m * 16 + fr; const float s = rstd[rl] * scale2; float mx = -3.0e38f;
#pragma unroll
                for (int bj = 0; bj < 2; ++bj)
#pragma unroll
                    for (int n = 0; n < 2; ++n) { f32x4 t = acc[ai][bj][m][n] * s; acc[ai][bj][m][n] = t; mx = fmaxf(mx, fmaxf(fmaxf(t[0], t[1]), fmaxf(t[2], t[3]))); }
                mx = fmaxf(mx, __shfl_xor(mx, 16)); mx = fmaxf(mx, __shfl_xor(mx, 32));
                if (fq == 0) xmax[rl * 4 + wc] = mx; }
        LDS_WAIT(); __builtin_amdgcn_s_barrier(); asm volatile("" ::: "memory");
#pragma unroll
        for (int ai = 0; ai < 2; ++ai)
#pragma unroll
            for (int m = 0; m < 4; ++m) { const int rl = ai * HALF + wr * 64 + m * 16 + fr; const f32x4 pm4 = *(const LAS f32x4*)(xmax + rl * 4);
                const float M = fmaxf(fmaxf(pm4[0], pm4[1]), fmaxf(pm4[2], pm4[3])); float sm = 0.f;
#pragma unroll
                for (int bj = 0; bj < 2; ++bj)
#pragma unroll
                    for (int n = 0; n < 2; ++n) { f32x4 t = acc[ai][bj][m][n];
#pragma unroll
                        for (int j = 0; j < 4; ++j) { t[j] = __builtin_amdgcn_exp2f(t[j] - M); sm += t[j]; }
                        acc[ai][bj][m][n] = t; }
                sm += __shfl_xor(sm, 16); sm += __shfl_xor(sm, 32);
                if (fq == 0) xsum[rl * 4 + wc] = sm; }
        LDS_WAIT(); __builtin_amdgcn_s_barrier(); asm volatile("" ::: "memory");
        const int col0 = u.pn * BM + wc * 32 + 8 * fq;
#pragma unroll
        for (int ai = 0; ai < 2; ++ai)
#pragma unroll
            for (int m = 0; m < 4; ++m) { const int rl = ai * HALF + wr * 64 + m * 16 + fr; const f32x4 s4 = *(const LAS f32x4*)(xsum + rl * 4);
                const float inv = (P8 ? 256.0f : 1.0f) / ((s4[0] + s4[1]) + (s4[2] + s4[3]));
                if constexpr (P8) { unsigned char* rowp = (unsigned char*)P + (size_t)(u.pm * BM + rl) * (NH * NMEM) + col0;
#pragma unroll
                    for (int bj = 0; bj < 2; ++bj) { const f32x4 v0 = acc[ai][bj][m][0] * inv, v1 = acc[ai][bj][m][1] * inv; unsigned w0 = 0u, w1 = 0u;
                        w0 = __builtin_amdgcn_cvt_pk_fp8_f32(v0[0], v0[1], w0, false); w0 = __builtin_amdgcn_cvt_pk_fp8_f32(v0[2], v0[3], w0, true);
                        w1 = __builtin_amdgcn_cvt_pk_fp8_f32(v1[0], v1[1], w1, false); w1 = __builtin_amdgcn_cvt_pk_fp8_f32(v1[2], v1[3], w1, true);
                        u32x2 w; w.x = w0; w.y = w1; *(u32x2*)(rowp + bj * HALF) = w; } }
                else { bf16* rowp = P + (size_t)(u.pm * BM + rl) * (NH * NMEM) + col0;
#pragma unroll
                    for (int bj = 0; bj < 2; ++bj) { const f32x4 v0 = acc[ai][bj][m][0] * inv, v1 = acc[ai][bj][m][1] * inv;
                        u32x4 w; w.x = cvt_pk_bf16(v0[0], v0[1]); w.y = cvt_pk_bf16(v0[2], v0[3]); w.z = cvt_pk_bf16(v1[0], v1[1]); w.w = cvt_pk_bf16(v1[2], v1[3]);
                        *(u32x4*)(rowp + bj * HALF) = w; } } }
    }
};
struct EpiSwiglu {
    bf16* O; int ldc; const LAS float* rstd;
    __device__ __forceinline__ void operator()(const Acc& acc, const Unit& u, int wr, int wc, int fr, int fq) const {
        const int col0 = u.pn * HALF + wc * 32 + 8 * fq;
#pragma unroll
        for (int ai = 0; ai < 2; ++ai)
#pragma unroll
            for (int m = 0; m < 4; ++m) { const int rl = ai * HALF + wr * 64 + m * 16 + fr; const float s = rstd[rl];
                float o[8];
#pragma unroll
                for (int n = 0; n < 2; ++n)
#pragma unroll
                    for (int j = 0; j < 4; ++j) { const float a = acc[ai][0][m][n][j] * s, b = acc[ai][1][m][n][j] * s; o[n * 4 + j] = a * sigmoidf_(a) * b; }
                u32x4 w; w.x = cvt_pk_bf16(o[0], o[1]); w.y = cvt_pk_bf16(o[2], o[3]); w.z = cvt_pk_bf16(o[4], o[5]); w.w = cvt_pk_bf16(o[6], o[7]);
                *(u32x4*)(O + (size_t)(u.pm * BM + rl) * ldc + col0) = w; }
    }
};
struct EpiSwigluI8 {
    bf16* O; int ldc; const LAS float* rowfac; const float* colsc;
    __device__ __forceinline__ void operator()(const Acc& acc, const Unit& u, int wr, int wc, int fr, int fq) const {
        const int col0 = u.pn * HALF + wc * 32 + 8 * fq, nt0 = u.pn * BM + wc * 32 + 8 * fq;
        f32x4 ca[2], cb[2];
#pragma unroll
        for (int n = 0; n < 2; ++n) { ca[n] = *(const GAS f32x4*)(colsc + nt0 + 4 * n); cb[n] = *(const GAS f32x4*)(colsc + nt0 + HALF + 4 * n); }
#pragma unroll
        for (int ai = 0; ai < 2; ++ai)
#pragma unroll
            for (int m = 0; m < 4; ++m) { const int rl = ai * HALF + wr * 64 + m * 16 + fr; const float rf = rowfac[rl]; float o[8];
#pragma unroll
                for (int n = 0; n < 2; ++n) { const v4i ia = __builtin_bit_cast(v4i, acc[ai][0][m][n]), ib = __builtin_bit_cast(v4i, acc[ai][1][m][n]);
#pragma unroll
                    for (int j = 0; j < 4; ++j) { const float a = (float)ia[j] * (rf * ca[n][j]), b = (float)ib[j] * (rf * cb[n][j]); o[n * 4 + j] = a * sigmoidf_(a) * b; } }
                u32x4 w; w.x = cvt_pk_bf16(o[0], o[1]); w.y = cvt_pk_bf16(o[2], o[3]); w.z = cvt_pk_bf16(o[4], o[5]); w.w = cvt_pk_bf16(o[6], o[7]);
                *(u32x4*)(O + (size_t)(u.pm * BM + rl) * ldc + col0) = w; }
    }
};
template <bool WB, bool ST, bool HALFSC, bool W8 = false, bool WF = false, bool S8 = false, bool XF = false> struct EpiRes {
    static constexpr float scale = (HALFSC ? 0.5f : 1.0f) * (S8 ? 0.00390625f : 1.0f);
    float* out; bf16* xb; float* stats; unsigned char* xb8; const float* xf;
    __device__ __forceinline__ void operator()(const Acc& acc, const Unit& u, int wr, int wc, int fr, int fq) const {
        const int col0 = u.pn * BM + wc * 32 + 8 * fq;
#pragma unroll
        for (int ai = 0; ai < 2; ++ai)
#pragma unroll
            for (int m = 0; m < 4; ++m) { const int r = u.pm * BM + ai * HALF + wr * 64 + m * 16 + fr; const size_t off = (size_t)r * DM + col0; float ss = 0.f;
#pragma unroll
                for (int bj = 0; bj < 2; ++bj) { f32x4 h0, h1;
                    if constexpr (XF) { h0 = *(const f32x4*)(xf + off + bj * HALF); h1 = *(const f32x4*)(xf + off + bj * HALF + 4); }
                    else { const u32x4 g = *(const u32x4*)(xb + off + bj * HALF);
                        h0 = (f32x4){bf_lo(g.x), bf_hi(g.x), bf_lo(g.y), bf_hi(g.y)}; h1 = (f32x4){bf_lo(g.z), bf_hi(g.z), bf_lo(g.w), bf_hi(g.w)}; }
                    const f32x4 v0 = h0 + acc[ai][bj][m][0] * scale, v1 = h1 + acc[ai][bj][m][1] * scale;
                    if (WF) { *(f32x4*)(out + off + bj * HALF) = v0; *(f32x4*)(out + off + bj * HALF + 4) = v1; }
                    if (WB) { u32x4 w; w.x = cvt_pk_bf16(v0[0], v0[1]); w.y = cvt_pk_bf16(v0[2], v0[3]); w.z = cvt_pk_bf16(v1[0], v1[1]); w.w = cvt_pk_bf16(v1[2], v1[3]);
                        *(u32x4*)(xb + off + bj * HALF) = w; }
                    if (W8) { unsigned w0 = 0u, w1 = 0u; w0 = __builtin_amdgcn_cvt_pk_fp8_f32(v0[0], v0[1], w0, false); w0 = __builtin_amdgcn_cvt_pk_fp8_f32(v0[2], v0[3], w0, true);
                        w1 = __builtin_amdgcn_cvt_pk_fp8_f32(v1[0], v1[1], w1, false); w1 = __builtin_amdgcn_cvt_pk_fp8_f32(v1[2], v1[3], w1, true);
                        u32x2 w8; w8.x = w0; w8.y = w1; *(u32x2*)(xb8 + off + bj * HALF) = w8; }
                    if (ST) ss += (v0[0] * v0[0] + v0[1] * v0[1]) + (v0[2] * v0[2] + v0[3] * v0[3]) + (v1[0] * v1[0] + v1[1] * v1[1]) + (v1[2] * v1[2] + v1[3] * v1[3]); }
                if (ST) { ss += __shfl_xor(ss, 16); ss += __shfl_xor(ss, 32); if (fq == 0) stats[(size_t)r * 64 + u.pn * 4 + wc] = ss; }
                asm volatile("" ::: "memory"); }
    }
};
struct EpiMix {
    bf16* ussm; bf16* cb; bf16* zc; bf16* ga; bf16* gb; const LAS float* rstd;
    __device__ __forceinline__ void operator()(const Acc& acc, const Unit& u, int wr, int wc, int fr, int fq) const {
        const int pn = u.pn;
        if (pn >= 16 && pn < 32) {
            const int col0 = (pn - 16) * HALF + wc * 32 + 8 * fq;
#pragma unroll
            for (int ai = 0; ai < 2; ++ai)
#pragma unroll
                for (int m = 0; m < 4; ++m) { const int rl = ai * HALF + wr * 64 + m * 16 + fr; const float s = rstd[rl]; float o[8];
#pragma unroll
                    for (int n = 0; n < 2; ++n)
#pragma unroll
                        for (int j = 0; j < 4; ++j) o[n * 4 + j] = (acc[ai][0][m][n][j] * s) * (acc[ai][1][m][n][j] * s);
                    u32x4 w; w.x = cvt_pk_bf16(o[0], o[1]); w.y = cvt_pk_bf16(o[2], o[3]); w.z = cvt_pk_bf16(o[4], o[5]); w.w = cvt_pk_bf16(o[6], o[7]);
                    *(u32x4*)(zc + (size_t)(u.pm * BM + rl) * DCONV + col0) = w; }
        } else {
            bf16* O; int ldc, ct; bool sg;
            if (pn < 8) { O = ussm; ldc = DSSM; ct = pn; sg = false; } else if (pn < 16) { O = cb; ldc = DCONV; ct = pn - 8; sg = false; }
            else if (pn < 48) { O = ga; ldc = DM; ct = pn - 32; sg = true; } else { O = gb; ldc = DM; ct = pn - 48; sg = true; }
            const int col0 = ct * BM + wc * 32 + 8 * fq;
#pragma unroll
            for (int ai = 0; ai < 2; ++ai)
#pragma unroll
                for (int m = 0; m < 4; ++m) { const int rl = ai * HALF + wr * 64 + m * 16 + fr; const float s = rstd[rl];
                    bf16* rowp = O + (size_t)(u.pm * BM + rl) * ldc + col0;
#pragma unroll
                    for (int bj = 0; bj < 2; ++bj) { f32x4 v0 = acc[ai][bj][m][0] * s, v1 = acc[ai][bj][m][1] * s;
                        if (sg) {
#pragma unroll
                            for (int j = 0; j < 4; ++j) { v0[j] = sigmoidf_(v0[j]); v1[j] = sigmoidf_(v1[j]); } }
                        u32x4 w; w.x = cvt_pk_bf16(v0[0], v0[1]); w.y = cvt_pk_bf16(v0[2], v0[3]); w.z = cvt_pk_bf16(v1[0], v1[1]); w.w = cvt_pk_bf16(v1[2], v1[3]);
                        *(u32x4*)(rowp + bj * HALF) = w; } }
        }
    }
};
struct EpiMixI8 {
    bf16* ussm; bf16* cb; bf16* ga; bf16* gb; const LAS float* rowfac; const float* colsc;
    __device__ __forceinline__ void operator()(const Acc& acc, const Unit& u, int wr, int wc, int fr, int fq) const {
        const int pn = u.pn + (u.pn >= 16 ? 16 : 0), nt0 = pn * BM + wc * 32 + 8 * fq;
        f32x4 cs[2][2];
#pragma unroll
        for (int bj = 0; bj < 2; ++bj)
#pragma unroll
            for (int n = 0; n < 2; ++n) cs[bj][n] = *(const GAS f32x4*)(colsc + nt0 + bj * HALF + 4 * n);
        bf16* O; int ldc, ct; bool sg;
        if (pn < 8) { O = ussm; ldc = DSSM; ct = pn; sg = false; } else if (pn < 16) { O = cb; ldc = DCONV; ct = pn - 8; sg = false; }
        else if (pn < 48) { O = ga; ldc = DM; ct = pn - 32; sg = true; } else { O = gb; ldc = DM; ct = pn - 48; sg = true; }
        const int col0 = ct * BM + wc * 32 + 8 * fq;
#pragma unroll
        for (int ai = 0; ai < 2; ++ai)
#pragma unroll
            for (int m = 0; m < 4; ++m) { const int rl = ai * HALF + wr * 64 + m * 16 + fr; const float rf = rowfac[rl];
                bf16* rowp = O + (size_t)(u.pm * BM + rl) * ldc + col0;
#pragma unroll
                for (int bj = 0; bj < 2; ++bj) { const v4i i0 = __builtin_bit_cast(v4i, acc[ai][bj][m][0]), i1 = __builtin_bit_cast(v4i, acc[ai][bj][m][1]); f32x4 v0, v1;
#pragma unroll
                    for (int j = 0; j < 4; ++j) { v0[j] = (float)i0[j] * (rf * cs[bj][0][j]); v1[j] = (float)i1[j] * (rf * cs[bj][1][j]); }
                    if (sg) {
#pragma unroll
                        for (int j = 0; j < 4; ++j) { v0[j] = sigmoidf_(v0[j]); v1[j] = sigmoidf_(v1[j]); } }
                    u32x4 w; w.x = cvt_pk_bf16(v0[0], v0[1]); w.y = cvt_pk_bf16(v0[2], v0[3]); w.z = cvt_pk_bf16(v1[0], v1[1]); w.w = cvt_pk_bf16(v1[2], v1[3]);
                    *(u32x4*)(rowp + bj * HALF) = w; } }
    }
};
struct EpiZc {
    bf16* zc; const LAS float* rstd;
    __device__ __forceinline__ void operator()(const Acc& acc, const Unit& u, int wr, int wc, int fr, int fq) const {
        const int col0 = u.pn * HALF + wc * 32 + 8 * fq;
#pragma unroll
        for (int ai = 0; ai < 2; ++ai)
#pragma unroll
            for (int m = 0; m < 4; ++m) { const int rl = ai * HALF + wr * 64 + m * 16 + fr; const float s = rstd[rl]; float o[8];
#pragma unroll
                for (int n = 0; n < 2; ++n)
#pragma unroll
                    for (int j = 0; j < 4; ++j) o[n * 4 + j] = (acc[ai][0][m][n][j] * s) * (acc[ai][1][m][n][j] * s);
                u32x4 w; w.x = cvt_pk_bf16(o[0], o[1]); w.y = cvt_pk_bf16(o[2], o[3]); w.z = cvt_pk_bf16(o[4], o[5]); w.w = cvt_pk_bf16(o[6], o[7]);
                *(u32x4*)(zc + (size_t)(u.pm * BM + rl) * DCONV + col0) = w; }
    }
};
struct EpiGate8 {
    bf16* ga; bf16* gb; const LAS float* rstd;
    __device__ __forceinline__ void operator()(const Acc& acc, const Unit& u, int wr, int wc, int fr, int fq) const {
        bf16* O = u.pn < 16 ? ga : gb; const int col0 = (u.pn & 15) * BM + wc * 32 + 8 * fq;
#pragma unroll
        for (int ai = 0; ai < 2; ++ai)
#pragma unroll
            for (int m = 0; m < 4; ++m) { const int rl = ai * HALF + wr * 64 + m * 16 + fr; const float s = rstd[rl] * 0.00390625f;
                bf16* rowp = O + (size_t)(u.pm * BM + rl) * DM + col0;
#pragma unroll
                for (int bj = 0; bj < 2; ++bj) { f32x4 v0 = acc[ai][bj][m][0] * s, v1 = acc[ai][bj][m][1] * s;
#pragma unroll
                    for (int j = 0; j < 4; ++j) { v0[j] = sigmoidf_(v0[j]); v1[j] = sigmoidf_(v1[j]); }
                    u32x4 w; w.x = cvt_pk_bf16(v0[0], v0[1]); w.y = cvt_pk_bf16(v0[2], v0[3]); w.z = cvt_pk_bf16(v1[0], v1[1]); w.w = cvt_pk_bf16(v1[2], v1[3]);
                    *(u32x4*)(rowp + bj * HALF) = w; } }
    }
};
struct EpiConvOut {
    const bf16* gb; bf16* tmp;
    __device__ __forceinline__ void operator()(const Acc& acc, const Unit& u, int wr, int wc, int fr, int fq) const {
        const int col0 = u.pn * BM + wc * 32 + 8 * fq;
#pragma unroll
        for (int ai = 0; ai < 2; ++ai)
#pragma unroll
            for (int m = 0; m < 4; ++m) { const size_t off = (size_t)(u.pm * BM + ai * HALF + wr * 64 + m * 16 + fr) * DM + col0;
#pragma unroll
                for (int bj = 0; bj < 2; ++bj) { const u32x4 g = *(const u32x4*)(gb + off + bj * HALF); const f32x4 a0 = acc[ai][bj][m][0], a1 = acc[ai][bj][m][1];
                    u32x4 w; w.x = cvt_pk_bf16(bf_lo(g.x) * a0[0], bf_hi(g.x) * a0[1]); w.y = cvt_pk_bf16(bf_lo(g.y) * a0[2], bf_hi(g.y) * a0[3]);
                    w.z = cvt_pk_bf16(bf_lo(g.z) * a1[0], bf_hi(g.z) * a1[1]); w.w = cvt_pk_bf16(bf_lo(g.w) * a1[2], bf_hi(g.w) * a1[3]);
                    *(u32x4*)(tmp + off + bj * HALF) = w; }
                asm volatile("" ::: "memory"); }
    }
};
struct EpiGlu {
    const bf16* ga; bf16* tmp;
    __device__ __forceinline__ void operator()(const Acc& acc, const Unit& u, int wr, int wc, int fr, int fq) const {
        const int col0 = u.pn * HALF + wc * 32 + 8 * fq;
#pragma unroll
        for (int ai = 0; ai < 2; ++ai)
#pragma unroll
            for (int m = 0; m < 4; ++m) { const size_t off = (size_t)(u.pm * BM + ai * HALF + wr * 64 + m * 16 + fr) * DM + col0;
                const u32x4 g = *(const u32x4*)(ga + off), t = *(const u32x4*)(tmp + off);
                const unsigned gw[4] = {g.x, g.y, g.z, g.w}, tw[4] = {t.x, t.y, t.z, t.w}; unsigned ow[4];
#pragma unroll
                for (int h = 0; h < 4; ++h) { const int n = h >> 1, j = (h & 1) * 2;
                    const float ya0 = acc[ai][0][m][n][j] * sigmoidf_(acc[ai][1][m][n][j]), ya1 = acc[ai][0][m][n][j + 1] * sigmoidf_(acc[ai][1][m][n][j + 1]);
                    ow[h] = cvt_pk_bf16(bf_lo(tw[h]) + bf_lo(gw[h]) * ya0, bf_hi(tw[h]) + bf_hi(gw[h]) * ya1); }
                u32x4 w; w.x = ow[0]; w.y = ow[1]; w.z = ow[2]; w.w = ow[3];
                *(u32x4*)(tmp + off) = w;
                asm volatile("" ::: "memory"); }
    }
};
}

#define XB_TMO      128
#define XB_XCNT(j)  (256  + 64 * (j))
#define XB_XSUB(j)  (1280 + 64 * (j))
#define XB_XGEN(j)  (2304 + 64 * (j))
#define XB_TOP      3328
#define XB_TOPGEN   3392
#define XCD_BAR_WORDS 3456
#define XB_SPIN_CAP (1u << 18)
__device__ __forceinline__ unsigned xb_ld(unsigned* p)              { return __hip_atomic_load(p, __ATOMIC_RELAXED, __HIP_MEMORY_SCOPE_AGENT); }
__device__ __forceinline__ unsigned xb_add(unsigned* p, unsigned v) { return __hip_atomic_fetch_add(p, v, __ATOMIC_RELAXED, __HIP_MEMORY_SCOPE_AGENT); }
__device__ __forceinline__ unsigned xb_xcc_id() { return (unsigned)__builtin_amdgcn_s_getreg((3 << 11) | 20) & 0xFu; }
#define XB_SPIN(cond, bar) do { unsigned _sp = 0; while (cond) { __builtin_amdgcn_s_sleep(1); \
    if ((++_sp & 255u) == 0u) { if (xb_ld(&(bar)[XB_TMO])) break; if (_sp > XB_SPIN_CAP) { atomicAdd(&(bar)[XB_TMO], 1u); break; } } } } while (0)
struct XcdBarrier { unsigned* bar; unsigned x; volatile LAS unsigned* st; };
__device__ __forceinline__ XcdBarrier xcd_barrier_post(unsigned* bar, volatile LAS unsigned* st) {
    XcdBarrier b; b.bar = bar; b.x = xb_xcc_id(); b.st = st;
    if (threadIdx.x == 0) (void)xb_add(&bar[XB_XCNT(b.x)], 1u);
    return b;
}
__device__ __forceinline__ void xcd_barrier_complete(unsigned* bar, unsigned x, unsigned& nloc, unsigned& nx) {
    const unsigned G = gridDim.x * gridDim.y * gridDim.z;
    unsigned sum, cnt, mine, sp = 0u;
    for (;;) {
        sum = 0u; cnt = 0u; mine = 0u;
#pragma unroll
        for (unsigned j = 0; j < 16; ++j) { const unsigned c = xb_ld(&bar[XB_XCNT(j)]); sum += c; cnt += (c > 0u) ? 1u : 0u; mine = (j == x) ? c : mine; }
        if (sum == G) break;
        __builtin_amdgcn_s_sleep(1);
        if ((++sp & 255u) == 0u) { if (xb_ld(&bar[XB_TMO])) break; if (sp > XB_SPIN_CAP) { atomicAdd(&bar[XB_TMO], 1u); break; } }
    }
    nloc = mine > 0u ? mine : 1u; nx = cnt > 0u ? cnt : 1u;
}
__device__ __forceinline__ void xcd_barrier(const XcdBarrier& b) {
    asm volatile("s_waitcnt vmcnt(0)" ::: "memory");
    __syncthreads();
    if (threadIdx.x == 0) {
        unsigned* bar = b.bar;
        __builtin_amdgcn_s_waitcnt(0);
        unsigned nloc = b.st[0], nx = b.st[1];
        if (nloc == 0u) { xcd_barrier_complete(bar, b.x, nloc, nx); b.st[0] = nloc; b.st[1] = nx; }
        const unsigned old = xb_add(&bar[XB_XSUB(b.x)], 1u);
        const unsigned gen = old / nloc;
        if (old + 1u == (gen + 1u) * nloc) {
            __builtin_amdgcn_fence(__ATOMIC_RELEASE, "agent");
            asm volatile("s_waitcnt vmcnt(0)" ::: "memory");
            const unsigned og = xb_add(&bar[XB_TOP], 1u);
            const unsigned tg = og / nx;
            if (og + 1u == (tg + 1u) * nx) xb_add(&bar[XB_TOPGEN], 1u);
            else XB_SPIN(xb_ld(&bar[XB_TOPGEN]) == tg, bar);
            __builtin_amdgcn_fence(__ATOMIC_ACQUIRE, "agent");
            xb_add(&bar[XB_XGEN(b.x)], 1u);
            asm volatile("s_waitcnt vmcnt(0)" ::: "memory");
        } else {
            XB_SPIN(xb_ld(&bar[XB_XGEN(b.x)]) == gen, bar);
            __builtin_amdgcn_fence(__ATOMIC_ACQUIRE, "agent");
            asm volatile("s_waitcnt vmcnt(0)" ::: "memory");
        }
    }
    __syncthreads();
}

struct Args { const float* in[29]; float* out; unsigned char* ws; int ph_lo, ph_hi; };
enum { I_X = 0, I_MEM, I_F1N, I_F1IN, I_F1OUT, I_MIXN, I_MIXIN, I_ARE, I_AIM, I_LOGDT, I_BRE, I_BIM, I_CRE, I_CIM, I_SSMD, I_GLUW, I_CONVW, I_CONVOUT, I_MIXOUT,
       I_XN, I_MEMN, I_WQ, I_WK, I_WV, I_WO, I_F2N, I_F2IN, I_F2OUT, I_FINN };
constexpr int NPHASE = 17;

__device__ __forceinline__ int rowmap(int mapk, int nb) {
    if (mapk == 1) return nb < 86 ? 256 * nb : 256 * (nb - 86) + 128;
    if (mapk == 2) return nb < 32 ? 128 * nb : (nb < 48 ? 4096 + 256 * (nb - 32) : (nb < 64 ? 4096 + 256 * (nb - 48) + 128 : 128 * nb));
    if (mapk == 3) return nb < 32 ? 256 * nb : 256 * (nb - 32) + 128;
    return 128 * nb;
}
__device__ __forceinline__ void p0_item(const float* W, const float* gain, int K, int N, bf16* WT, int mapk, LAS unsigned* scr, int item, int lane, int nblk_use = 0, int nb0 = 0) {
    const int nblk = nblk_use ? nblk_use : N / 128, kb = item / nblk, nb = nb0 + item % nblk, k0 = 64 * kb, n0 = 128 * nb;
    const int nrow0 = rowmap(mapk, nb);
    const int x = lane & 31, half = lane >> 5;
#pragma unroll 8
    for (int kk = 0; kk < 16; ++kk) {
        const int kp = kk + 16 * half, k = k0 + 2 * kp;
        const f32x4 a = *(const GAS f32x4*)(W + (size_t)k * N + n0 + 4 * x), b = *(const GAS f32x4*)(W + (size_t)(k + 1) * N + n0 + 4 * x);
        const float g0 = gain ? gain[k] : 1.0f, g1 = gain ? gain[k + 1] : 1.0f;
        u32x4 d; d.x = pk2(a.x * g0, b.x * g1); d.y = pk2(a.y * g0, b.y * g1); d.z = pk2(a.z * g0, b.z * g1); d.w = pk2(a.w * g0, b.w * g1);
        *(LAS u32x4*)(scr + kp * 132 + 4 * x) = d;
    }
    LDS_WAIT();
    const int c8 = lane & 7;
#pragma unroll 4
    for (int it = 0; it < 16; ++it) { const int n = it * 8 + (lane >> 3);
        u32x4 o; o.x = scr[(4 * c8 + 0) * 132 + n]; o.y = scr[(4 * c8 + 1) * 132 + n]; o.z = scr[(4 * c8 + 2) * 132 + n]; o.w = scr[(4 * c8 + 3) * 132 + n];
        *(GAS u32x4*)(WT + (size_t)(nrow0 + n) * K + k0 + 8 * c8) = o; }
    LDS_WAIT();
}
__device__ __forceinline__ void p0_item8(const float* W, const float* gain, float sc, int K, int N, int ncol0, int nblk, unsigned char* WT, LAS unsigned* scr, int item, int lane) {
    const int kb = item / nblk, nb = item % nblk, k0 = 128 * kb, n0 = ncol0 + 128 * nb;
    const int x = lane & 31, half = lane >> 5;
#pragma unroll 4
    for (int kk = 0; kk < 16; ++kk) {
        const int kq = kk + 16 * half, k = k0 + 4 * kq;
        f32x4 r[4];
#pragma unroll
        for (int j = 0; j < 4; ++j) r[j] = *(const GAS f32x4*)(W + (size_t)(k + j) * N + n0 + 4 * x) * (gain[k + j] * sc);
        unsigned d[4];
#pragma unroll
        for (int i = 0; i < 4; ++i) { unsigned w = 0u; w = __builtin_amdgcn_cvt_pk_fp8_f32(r[0][i], r[1][i], w, false); w = __builtin_amdgcn_cvt_pk_fp8_f32(r[2][i], r[3][i], w, true); d[i] = w; }
        u32x4 dv; dv.x = d[0]; dv.y = d[1]; dv.z = d[2]; dv.w = d[3];
        *(LAS u32x4*)(scr + kq * 132 + 4 * x) = dv;
    }
    LDS_WAIT();
    const int c8 = lane & 7;
#pragma unroll 4
    for (int it = 0; it < 16; ++it) { const int n = it * 8 + (lane >> 3);
        u32x4 o; o.x = scr[(4 * c8 + 0) * 132 + n]; o.y = scr[(4 * c8 + 1) * 132 + n]; o.z = scr[(4 * c8 + 2) * 132 + n]; o.w = scr[(4 * c8 + 3) * 132 + n];
        *(GAS u32x4*)(WT + (size_t)(128 * nb + n) * K + k0 + 16 * c8) = o; }
    LDS_WAIT();
}
__device__ __forceinline__ unsigned pack_i8x4(float a, float b, float c, float d) {
    const int q0 = (int)__builtin_rintf(a), q1 = (int)__builtin_rintf(b), q2 = (int)__builtin_rintf(c), q3 = (int)__builtin_rintf(d);
    return (unsigned)(q0 & 255) | ((unsigned)(q1 & 255) << 8) | ((unsigned)(q2 & 255) << 16) | ((unsigned)q3 << 24);
}
__device__ __forceinline__ void p0_colmax_item(const float* W, const float* gain, int N, int mapk, unsigned* colmax, int item, int lane, bool skip32 = false) {
    const int nblk = N / 128 - (skip32 ? 32 : 0), kb = item / nblk, nbr = item % nblk, nb = nbr + ((skip32 && nbr >= 32) ? 32 : 0), k0 = 128 * kb, n0 = 128 * nb, nrow0 = rowmap(mapk, nb);
    const int x = lane & 31, half = lane >> 5;
    float m0 = 0.f, m1 = 0.f, m2 = 0.f, m3 = 0.f;
#pragma unroll 8
    for (int kk = 0; kk < 64; ++kk) { const int k = k0 + 2 * kk + half;
        const f32x4 a = __builtin_nontemporal_load((const GAS f32x4*)(W + (size_t)k * N + n0 + 4 * x)) * gain[k];
        m0 = fmaxf(m0, fabsf(a.x)); m1 = fmaxf(m1, fabsf(a.y)); m2 = fmaxf(m2, fabsf(a.z)); m3 = fmaxf(m3, fabsf(a.w)); }
    m0 = fmaxf(m0, __shfl_xor(m0, 32)); m1 = fmaxf(m1, __shfl_xor(m1, 32)); m2 = fmaxf(m2, __shfl_xor(m2, 32)); m3 = fmaxf(m3, __shfl_xor(m3, 32));
    if (half == 0) { unsigned* c = colmax + nrow0 + 4 * x;
        atomicMax(c + 0, __builtin_bit_cast(unsigned, m0)); atomicMax(c + 1, __builtin_bit_cast(unsigned, m1)); atomicMax(c + 2, __builtin_bit_cast(unsigned, m2)); atomicMax(c + 3, __builtin_bit_cast(unsigned, m3)); }
}
__device__ __forceinline__ void p0_item_i8(const float* W, const float* gain, int K, int N, int mapk, const unsigned* colmax, float* colsc, unsigned char* WT, LAS unsigned* scr, int item, int lane, bool skip32 = false) {
    const int nblk = N / 128 - (skip32 ? 32 : 0), kb = item / nblk, nbr = item % nblk, nb = nbr + ((skip32 && nbr >= 32) ? 32 : 0), k0 = 128 * kb, n0 = 128 * nb, nrow0 = rowmap(mapk, nb);
    const int x = lane & 31, half = lane >> 5;
    float inv[4];
#pragma unroll
    for (int i = 0; i < 4; ++i) { const float cm = __builtin_bit_cast(float, __hip_atomic_load(colmax + nrow0 + 4 * x + i, __ATOMIC_RELAXED, __HIP_MEMORY_SCOPE_AGENT)); inv[i] = cm > 0.f ? 127.0f / cm : 0.f;
        if (kb == 0 && half == 0) colsc[nrow0 + 4 * x + i] = cm > 0.f ? cm * (1.0f / 127.0f) : 1.0f; }
#pragma unroll 4
    for (int kk = 0; kk < 16; ++kk) {
        const int kq = kk + 16 * half, k = k0 + 4 * kq;
        f32x4 r[4];
#pragma unroll
        for (int j = 0; j < 4; ++j) r[j] = __builtin_nontemporal_load((const GAS f32x4*)(W + (size_t)(k + j) * N + n0 + 4 * x)) * gain[k + j];
        u32x4 dv; dv.x = pack_i8x4(r[0][0] * inv[0], r[1][0] * inv[0], r[2][0] * inv[0], r[3][0] * inv[0]); dv.y = pack_i8x4(r[0][1] * inv[1], r[1][1] * inv[1], r[2][1] * inv[1], r[3][1] * inv[1]);
        dv.z = pack_i8x4(r[0][2] * inv[2], r[1][2] * inv[2], r[2][2] * inv[2], r[3][2] * inv[2]); dv.w = pack_i8x4(r[0][3] * inv[3], r[1][3] * inv[3], r[2][3] * inv[3], r[3][3] * inv[3]);
        *(LAS u32x4*)(scr + kq * 132 + 4 * x) = dv;
    }
    LDS_WAIT();
    const int c8 = lane & 7;
#pragma unroll 4
    for (int it = 0; it < 16; ++it) { const int n = it * 8 + (lane >> 3);
        u32x4 o; o.x = scr[(4 * c8 + 0) * 132 + n]; o.y = scr[(4 * c8 + 1) * 132 + n]; o.z = scr[(4 * c8 + 2) * 132 + n]; o.w = scr[(4 * c8 + 3) * 132 + n];
        *(GAS u32x4*)(WT + (size_t)(nrow0 + n) * K + k0 + 16 * c8) = o; }
    LDS_WAIT();
}
__device__ __forceinline__ void slab_quant_i8(const float* W, const float* gain, int N, int n0, int nrow, unsigned char* WT, float* colsc, LAS float* red, int tid) {
    const int lane = tid & 63, w = tid >> 6, c = lane & 3, rg = lane >> 2, k0 = 512 * w + 32 * rg;
    const GAS float* src = (const GAS float*)W + (size_t)k0 * N + n0 + 4 * c;
    f32x4 v[32];
#pragma unroll
    for (int i = 0; i < 32; ++i) v[i] = *(const GAS f32x4*)(src + (size_t)i * N);
    float m0 = 0.f, m1 = 0.f, m2 = 0.f, m3 = 0.f;
#pragma unroll
    for (int i4 = 0; i4 < 8; ++i4) { const f32x4 g = *(const GAS f32x4*)(gain + k0 + 4 * i4);
#pragma unroll
        for (int e = 0; e < 4; ++e) { const int i = 4 * i4 + e; v[i] = v[i] * g[e];
            m0 = fmaxf(m0, fabsf(v[i].x)); m1 = fmaxf(m1, fabsf(v[i].y)); m2 = fmaxf(m2, fabsf(v[i].z)); m3 = fmaxf(m3, fabsf(v[i].w)); } }
#pragma unroll
    for (int o = 4; o < 64; o <<= 1) { m0 = fmaxf(m0, __shfl_xor(m0, o)); m1 = fmaxf(m1, __shfl_xor(m1, o)); m2 = fmaxf(m2, __shfl_xor(m2, o)); m3 = fmaxf(m3, __shfl_xor(m3, o)); }
    if (rg == 0) { red[w * 16 + 4 * c + 0] = m0; red[w * 16 + 4 * c + 1] = m1; red[w * 16 + 4 * c + 2] = m2; red[w * 16 + 4 * c + 3] = m3; }
    __syncthreads();
    float inv[4];
#pragma unroll
    for (int j = 0; j < 4; ++j) { float cm = 0.f;
#pragma unroll
        for (int ww = 0; ww < 8; ++ww) cm = fmaxf(cm, red[ww * 16 + 4 * c + j]);
        inv[j] = cm > 0.f ? 127.0f / cm : 0.f;
        if (w == 0 && rg == 0) colsc[nrow + 4 * c + j] = cm > 0.f ? cm * (1.0f / 127.0f) : 1.0f; }
#pragma unroll
    for (int j = 0; j < 4; ++j) { GAS u32x4* dst = (GAS u32x4*)(WT + (size_t)(nrow + 4 * c + j) * 4096 + k0);
#pragma unroll
        for (int h = 0; h < 2; ++h) { u32x4 o;
            o.x = pack_i8x4(v[16 * h + 0][j] * inv[j], v[16 * h + 1][j] * inv[j], v[16 * h + 2][j] * inv[j], v[16 * h + 3][j] * inv[j]);
            o.y = pack_i8x4(v[16 * h + 4][j] * inv[j], v[16 * h + 5][j] * inv[j], v[16 * h + 6][j] * inv[j], v[16 * h + 7][j] * inv[j]);
            o.z = pack_i8x4(v[16 * h + 8][j] * inv[j], v[16 * h + 9][j] * inv[j], v[16 * h + 10][j] * inv[j], v[16 * h + 11][j] * inv[j]);
            o.w = pack_i8x4(v[16 * h + 12][j] * inv[j], v[16 * h + 13][j] * inv[j], v[16 * h + 14][j] * inv[j], v[16 * h + 15][j] * inv[j]);
            dst[h] = o; } }
}
template <bool HASG = true> __device__ __forceinline__ void slab32_quant_i8(const float* W, const float* gain, int N, int n0, int nrow, unsigned char* WT, float* colsc, LAS float* red, LAS u32x2* spill, int tid) {
    const int lane = tid & 63, w = tid >> 6, c = lane & 7, rg = lane >> 3, k0 = 512 * w + 64 * rg;
    const __amdgpu_buffer_rsrc_t rs = __builtin_amdgcn_make_buffer_rsrc((void*)W, 0, (int)0xffffffffu, 0x00020000);
    const unsigned voff = (unsigned)(k0 * N + n0 + 4 * c) * 4u, rstep = (unsigned)N * 4u;
#define SLAB_LD(i) __builtin_bit_cast(f32x4, __builtin_amdgcn_raw_buffer_load_b128(rs, voff, (unsigned)(i) * rstep, 0))
    constexpr int NR = 30, NBATCH = 8;
    unsigned P[NR][2];
    float m0 = 0.f, m1 = 0.f, m2 = 0.f, m3 = 0.f;
    f32x4 va[NBATCH], vb[NBATCH];
#pragma unroll
    for (int i = 0; i < NBATCH; ++i) va[i] = SLAB_LD(i);
#pragma unroll
    for (int b = 0; b < 64 / NBATCH; ++b) {
        if (b < 64 / NBATCH - 1) {
#pragma unroll
            for (int i = 0; i < NBATCH; ++i) vb[i] = SLAB_LD(NBATCH * (b + 1) + i); }
        __builtin_amdgcn_sched_barrier(0);
#pragma unroll
        for (int i4 = 0; i4 < NBATCH / 4; ++i4) { f32x4 g = {1.f, 1.f, 1.f, 1.f}; if constexpr (HASG) g = *(const GAS f32x4*)(gain + k0 + NBATCH * b + 4 * i4);
#pragma unroll
            for (int e = 0; e < 4; ++e) { const int i = NBATCH * b + 4 * i4 + e; const f32x4 v = va[4 * i4 + e] * g[e];
                m0 = fmaxf(m0, fabsf(v.x)); m1 = fmaxf(m1, fabsf(v.y)); m2 = fmaxf(m2, fabsf(v.z)); m3 = fmaxf(m3, fabsf(v.w));
                const unsigned p0 = cvt_pk_bf16(v.x, v.y), p1 = cvt_pk_bf16(v.z, v.w);
                if (i < NR) { P[i][0] = p0; P[i][1] = p1; } else { u32x2 q; q.x = p0; q.y = p1; spill[(i - NR) * 512 + tid] = q; } } }
        __builtin_amdgcn_sched_barrier(0);
#pragma unroll
        for (int i = 0; i < NBATCH; ++i) va[i] = vb[i];
    }
#undef SLAB_LD
#pragma unroll
    for (int o = 8; o < 64; o <<= 1) { m0 = fmaxf(m0, __shfl_xor(m0, o)); m1 = fmaxf(m1, __shfl_xor(m1, o)); m2 = fmaxf(m2, __shfl_xor(m2, o)); m3 = fmaxf(m3, __shfl_xor(m3, o)); }
    if (rg == 0) { red[w * 32 + 4 * c + 0] = m0; red[w * 32 + 4 * c + 1] = m1; red[w * 32 + 4 * c + 2] = m2; red[w * 32 + 4 * c + 3] = m3; }
    __syncthreads();
    float inv[4];
#pragma unroll
    for (int j = 0; j < 4; ++j) { float cm = 0.f;
#pragma unroll
        for (int ww = 0; ww < 8; ++ww) cm = fmaxf(cm, red[ww * 32 + 4 * c + j]);
        inv[j] = cm > 0.f ? 127.0f / cm : 0.f;
        if (w == 0 && rg == 0) colsc[nrow + 4 * c + j] = cm > 0.f ? cm * (1.0f / 127.0f) : 1.0f; }
#pragma unroll
    for (int h = 0; h < 4; ++h) { unsigned o[4][4];
#pragma unroll
        for (int d = 0; d < 4; ++d) { unsigned q0[4], q1[4];
#pragma unroll
            for (int e = 0; e < 4; ++e) { const int i = 16 * h + 4 * d + e;
                if (i < NR) { q0[e] = P[i][0]; q1[e] = P[i][1]; } else { const u32x2 q = spill[(i - NR) * 512 + tid]; q0[e] = q.x; q1[e] = q.y; } }
            o[0][d] = pack_i8x4(bf_lo(q0[0]) * inv[0], bf_lo(q0[1]) * inv[0], bf_lo(q0[2]) * inv[0], bf_lo(q0[3]) * inv[0]);
            o[1][d] = pack_i8x4(bf_hi(q0[0]) * inv[1], bf_hi(q0[1]) * inv[1], bf_hi(q0[2]) * inv[1], bf_hi(q0[3]) * inv[1]);
            o[2][d] = pack_i8x4(bf_lo(q1[0]) * inv[2], bf_lo(q1[1]) * inv[2], bf_lo(q1[2]) * inv[2], bf_lo(q1[3]) * inv[2]);
            o[3][d] = pack_i8x4(bf_hi(q1[0]) * inv[3], bf_hi(q1[1]) * inv[3], bf_hi(q1[2]) * inv[3], bf_hi(q1[3]) * inv[3]); }
#pragma unroll
        for (int j = 0; j < 4; ++j) { u32x4 ov; ov.x = o[j][0]; ov.y = o[j][1]; ov.z = o[j][2]; ov.w = o[j][3];
            *(GAS u32x4*)(WT + (size_t)(nrow + 4 * c + j) * 4096 + k0 + 16 * h) = ov; } }
}
__device__ __forceinline__ void row_quant_i8(const float* xrow, bf16* orow, unsigned char* qrow, float* rowfac, int lane) {
    const GAS f32x4* xr = (const GAS f32x4*)xrow + lane;
    f32x4 v[16]; float s = 0.f, mx = 0.f;
#pragma unroll
    for (int j = 0; j < 16; ++j) { v[j] = __builtin_nontemporal_load(xr + 64 * j); s += (v[j].x * v[j].x + v[j].y * v[j].y) + (v[j].z * v[j].z + v[j].w * v[j].w);
        mx = fmaxf(mx, fmaxf(fmaxf(fabsf(v[j].x), fabsf(v[j].y)), fmaxf(fabsf(v[j].z), fabsf(v[j].w)))); }
    s = wave_sum(s); mx = wave_max(mx);
    const float inv = mx > 0.f ? 127.0f / mx : 0.f;
    if (lane == 0) *rowfac = (mx > 0.f ? mx * (1.0f / 127.0f) : 1.0f) / sqrtf(s * (1.0f / DM) + RMS_EPS);
    GAS u32x2* o8 = (GAS u32x2*)orow + lane; GAS unsigned* q4 = (GAS unsigned*)qrow + lane;
#pragma unroll
    for (int j = 0; j < 16; ++j) { if (orow) { u32x2 o; o.x = pk2(v[j].x, v[j].y); o.y = pk2(v[j].z, v[j].w); o8[64 * j] = o; } q4[64 * j] = pack_i8x4(v[j].x * inv, v[j].y * inv, v[j].z * inv, v[j].w * inv); }
}
__device__ __forceinline__ void row_quant_bf16_i8(const bf16* xrow, const float* stat_row, unsigned char* qrow, float* rowfac, int lane) {
    const GAS u32x2* xr = (const GAS u32x2*)xrow + lane;
    f32x4 v[16]; float mx = 0.f;
#pragma unroll
    for (int j = 0; j < 16; ++j) { const u32x2 w = xr[64 * j]; v[j] = (f32x4){bf_lo(w.x), bf_hi(w.x), bf_lo(w.y), bf_hi(w.y)};
        mx = fmaxf(mx, fmaxf(fmaxf(fabsf(v[j].x), fabsf(v[j].y)), fmaxf(fabsf(v[j].z), fabsf(v[j].w)))); }
    const float s = wave_sum(((const GAS float*)stat_row)[lane]); mx = wave_max(mx);
    const float inv = mx > 0.f ? 127.0f / mx : 0.f;
    if (lane == 0) *rowfac = (mx > 0.f ? mx * (1.0f / 127.0f) : 1.0f) / sqrtf(s * (1.0f / DM) + RMS_EPS);
    GAS unsigned* q4 = (GAS unsigned*)qrow + lane;
#pragma unroll
    for (int j = 0; j < 16; ++j) q4[64 * j] = pack_i8x4(v[j].x * inv, v[j].y * inv, v[j].z * inv, v[j].w * inv);
}
__device__ __forceinline__ void row_norm_quant_i8(const float* xrow, const float* gain, unsigned char* qrow, float* rowfac, int lane) {
    const GAS f32x4* xr = (const GAS f32x4*)xrow + lane;
    f32x4 v[16]; float s = 0.f, mx = 0.f;
#pragma unroll
    for (int j = 0; j < 16; ++j) { v[j] = xr[64 * j]; s += (v[j].x * v[j].x + v[j].y * v[j].y) + (v[j].z * v[j].z + v[j].w * v[j].w); }
    const float sc = 1.0f / sqrtf(wave_sum(s) * (1.0f / DM) + RMS_EPS);
#pragma unroll
    for (int j = 0; j < 16; ++j) { const f32x4 g = ((const GAS f32x4*)gain)[lane + 64 * j]; v[j] = v[j] * sc * g;
        mx = fmaxf(mx, fmaxf(fmaxf(fabsf(v[j].x), fabsf(v[j].y)), fmaxf(fabsf(v[j].z), fabsf(v[j].w)))); }
    mx = wave_max(mx);
    const float inv = mx > 0.f ? 127.0f / mx : 0.f;
    if (lane == 0) *rowfac = mx > 0.f ? mx * (1.0f / 127.0f) : 1.0f;
    GAS unsigned* q4 = (GAS unsigned*)qrow + lane;
#pragma unroll
    for (int j = 0; j < 16; ++j) q4[64 * j] = pack_i8x4(v[j].x * inv, v[j].y * inv, v[j].z * inv, v[j].w * inv);
}
__device__ __forceinline__ void row_to_bf16(const float* xrow, bf16* orow, float* stat_row, const float* gain, int lane) {
    const GAS f32x4* xr = (const GAS f32x4*)xrow + lane;
    f32x4 v[16]; float s = 0.f;
#pragma unroll
    for (int j = 0; j < 16; ++j) { v[j] = xr[64 * j]; s += (v[j].x * v[j].x + v[j].y * v[j].y) + (v[j].z * v[j].z + v[j].w * v[j].w); }
    s = wave_sum(s);
    float sc = 1.0f;
    if (gain) sc = 1.0f / sqrtf(s * (1.0f / DM) + RMS_EPS);
    if (stat_row) stat_row[lane] = (lane == 0) ? s : 0.f;
    GAS u32x2* o8 = (GAS u32x2*)orow + lane;
#pragma unroll
    for (int j = 0; j < 16; ++j) { f32x4 w = v[j] * sc;
        if (gain) { const f32x4 g = ((const GAS f32x4*)gain)[lane + 64 * j]; w = w * g; }
        u32x2 o; o.x = pk2(w.x, w.y); o.y = pk2(w.z, w.w); o8[64 * j] = o; }
}
__device__ __forceinline__ void row_scale_to_bf16(const float* xrow, bf16* orow, float sc, int lane) {
    const GAS f32x4* xr = (const GAS f32x4*)xrow + lane; GAS u32x2* o8 = (GAS u32x2*)orow + lane;
#pragma unroll
    for (int j = 0; j < 16; ++j) { const f32x4 w = xr[64 * j] * sc; u32x2 o; o.x = pk2(w.x, w.y); o.y = pk2(w.z, w.w); o8[64 * j] = o; }
}
__device__ __forceinline__ void rstd_table(const float* stats, int pm, LAS float* tab) {
    const int t = threadIdx.x, row = t >> 1, hf = t & 1;
    const GAS f32x4* p = (const GAS f32x4*)(stats + (size_t)(pm * 256 + row) * 64 + hf * 32);
    float s = 0.f;
#pragma unroll
    for (int j = 0; j < 8; ++j) { const f32x4 v = p[j]; s += (v.x + v.y) + (v.z + v.w); }
    s += __shfl_xor(s, 1);
    if (hf == 0) tab[row] = 1.0f / sqrtf(s * (1.0f / DM) + RMS_EPS);
    __syncthreads();
}


constexpr int SSM_NSEG = 4, SSM_SEGLEN = SEQ / SSM_NSEG;
template <bool FULL>
__device__ __forceinline__ void ssm_unit(LAS unsigned char* wl, const unsigned char* ws, const bf16* ussm, bf16* ys, const float* dskip, int b, int g, int seg, int lane) {
    const int tok = lane & 15, q = lane >> 4;
    LAS float* Vl = (LAS float*)wl;
    LAS unsigned char* Sl = wl + 8448;
    const float* LAM = (const float*)(ws + WS_SSMC); const bf16x8* BFR = (const bf16x8*)(ws + WS_SSMC + 128 * 1024); const bf16x8* CFR = (const bf16x8*)(ws + WS_SSMC + 1152 * 1024);
    float* ESEG = (float*)(ws + WS_ESEG);
    const float lr = LAM[2 * (g * GP + lane)], li = LAM[2 * (g * GP + lane) + 1];
    bf16x8 Bf[8], Cf[4];
#pragma unroll
    for (int mt = 0; mt < 8; ++mt) Bf[mt] = BFR[(g * 8 + mt) * 64 + lane];
    float dsk[4];
    if (FULL) {
#pragma unroll
        for (int ks = 0; ks < 4; ++ks) Cf[ks] = CFR[(g * 4 + ks) * 64 + lane];
#pragma unroll
        for (int r = 0; r < 4; ++r) dsk[r] = dskip[g * GH + 4 * q + r];
    }
    float sr = 0.f, si = 0.f;
    if (FULL && seg > 0) {
        float pr = lr, pi = li;
#pragma unroll
        for (int k = 0; k < 10; ++k) { const float nr = pr * pr - pi * pi, ni = 2.0f * pr * pi; pr = nr; pi = ni; }
        static_assert(SSM_SEGLEN == 1024, "lam^SEGLEN by 10 squarings");
        for (int j = 0; j < seg; ++j) { const f32x2 e = *(const GAS f32x2*)(ESEG + ((size_t)((b * NG + g) * SSM_NSEG + j) * GP + lane) * 2);
            const float nr = pr * sr - pi * si + e.x, ni = pr * si + pi * sr + e.y; sr = nr; si = ni; }
    }
    const bf16* ub = ussm + ((size_t)b * SEQ + (size_t)seg * SSM_SEGLEN) * DSSM + g * GH;
    bf16* yb = ys + ((size_t)b * SEQ + (size_t)seg * SSM_SEGLEN) * DSSM + g * GH;
    const bf16x8 zero8 = {0, 0, 0, 0, 0, 0, 0, 0};
    bf16x8 unext = (q < 2) ? *(const GAS bf16x8*)(ub + (size_t)tok * DSSM + 8 * q) : zero8;
    u32x2 snext = {0u, 0u};
    if (FULL) snext = *(const GAS u32x2*)(ub + (size_t)tok * DSSM + 4 * q);
    for (int c = 0; c < SSM_SEGLEN / 16; ++c) {
        const bf16x8 ucur = unext; const u32x2 scur = snext;
        if (c + 1 < SSM_SEGLEN / 16) { const size_t ro = (size_t)(16 * (c + 1) + tok) * DSSM;
            unext = (q < 2) ? *(const GAS bf16x8*)(ub + ro + 8 * q) : zero8; if (FULL) snext = *(const GAS u32x2*)(ub + ro + 4 * q); }
#pragma unroll
        for (int mt = 0; mt < 8; ++mt) { const f32x4 d = __builtin_amdgcn_mfma_f32_16x16x32_bf16(Bf[mt], ucur, (f32x4){0.f, 0.f, 0.f, 0.f}, 0, 0, 0);
            *(LAS f32x4*)(Vl + tok * 132 + 16 * mt + 4 * q) = d; }
        LDS_WAIT();
#pragma unroll
        for (int t = 0; t < 16; ++t) { const f32x2 v = *(const LAS f32x2*)(Vl + t * 132 + 2 * lane);
            const float nr = lr * sr - li * si + v.x, ni = lr * si + li * sr + v.y; sr = nr; si = ni;
            if (FULL) *(LAS unsigned*)(Sl + t * 272 + lane * 4) = cvt_pk_bf16(sr, si); }
        LDS_WAIT();
        if (FULL) {
            f32x4 y = {0.f, 0.f, 0.f, 0.f};
#pragma unroll
            for (int ks = 0; ks < 4; ++ks) { const bf16x8 sf = *(const LAS bf16x8*)(Sl + tok * 272 + (32 * ks + 8 * q) * 2);
                y = __builtin_amdgcn_mfma_f32_16x16x32_bf16(Cf[ks], sf, y, 0, 0, 0); }
            const float u0 = bf_lo(scur.x), u1 = bf_hi(scur.x), u2 = bf_lo(scur.y), u3 = bf_hi(scur.y);
            const float o0 = gelu1(y[0] + dsk[0] * u0), o1 = gelu1(y[1] + dsk[1] * u1), o2 = gelu1(y[2] + dsk[2] * u2), o3 = gelu1(y[3] + dsk[3] * u3);
            u32x2 w; w.x = cvt_pk_bf16(o0, o1); w.y = cvt_pk_bf16(o2, o3);
            *(GAS u32x2*)(yb + (size_t)(16 * c + tok) * DSSM + 4 * q) = w;
        }
    }
    if (!FULL) { f32x2 e; e.x = sr; e.y = si; *(GAS f32x2*)(ESEG + ((size_t)((b * NG + g) * SSM_NSEG + seg) * GP + lane) * 2) = e; }
}

__global__ void __launch_bounds__(NWAVES * 64, 2) mk_fwd(Args args) {
    extern __shared__ __attribute__((aligned(16))) unsigned char lds_raw[];
    LAS unsigned char* lds = (LAS unsigned char*)lds_raw;
    volatile LAS unsigned* MISC = (volatile LAS unsigned*)(lds + MISC_OFF);
    LAS float* rstd_tab = (LAS float*)(lds + RSTD_OFF);
#define FRESH_IDS() int tid = threadIdx.x; asm volatile("" : "+v"(tid)); const int lane = tid & 63, wave = __builtin_amdgcn_readfirstlane(tid >> 6); const int gw = bid * NWAVES + wave; (void)lane; (void)gw
    const int G = gridDim.x, bid = blockIdx.x;
    unsigned char* ws = args.ws;
    gu32* ctl = (gu32*)(ws + WS_CTL);
    for (int u = threadIdx.x; u < (LDS_BYTES - RSTD_OFF) / 4; u += NWAVES * 64) ((LAS unsigned*)(lds + RSTD_OFF))[u] = 0u;
    __syncthreads();
    XcdBarrier bar; bar.bar = (unsigned*)(ctl + CW_BAR); bar.x = 0; bar.st = nullptr;
    if (MK_ONE_LAUNCH) bar = xcd_barrier_post((unsigned*)(ctl + CW_BAR), MISC + 8);
    const int lo = args.ph_lo, hi = args.ph_hi;
#define IN(k) (lo <= (k) && (k) < hi)
#define SEAM(k) do { if (IN(k) && IN((k) + 1)) xcd_barrier(bar); } while (0)

    float* const hres = args.out;
    float* const stats = (float*)(ws + WS_STATS);
    bf16* const xb = (bf16*)(ws + WS_XB);
    unsigned char* const big = ws + WS_BIG;
    const int NGW = G * NWAVES;

    if (IN(0)) {
        FRESH_IDS();
        LAS unsigned* scr = (LAS unsigned*)(lds + wave * 16896);
        constexpr int I_FIN = (DM / 64) * (2 * DFF / 128), I_FOUT = (DFF / 64) * (DM / 128), I_MIX = (DM / 64) * 64, I_MIX8 = (DM / 128) * 64, I_GLU = (DSSM / 64) * (2 * DM / 128),
                      I_CO = (DCONV / 64) * (DM / 128), I_SQ = (DM / 64) * (DM / 128);
        constexpr int I_CM = (DM / 128) * (2 * DFF / 128);
        constexpr int I_CMX = (DM / 128) * (MIXC / 128 - 32);
        constexpr int I_MXB = (DM / 64) * 32;
#if MK_SLABQ
        {
            constexpr int NS_F = 2 * DFF / 32, NS_M = (MIXC - DM) / 32, NS_KV = MK_I8_KV ? 2 * DM / 32 : 0, NS = 2 * NS_F + NS_M + NS_KV;
            int itn = 0;
            for (int sl = bid; sl < NS; sl += G, ++itn) {
                LAS float* red = (LAS float*)lds + (itn & 1) * 256;
                LAS u32x2* sp2 = (LAS u32x2*)(lds + 4096);
                if (sl < NS_F) { const int nb = sl >> 2;
                    slab32_quant_i8(args.in[I_F1IN], args.in[I_F1N], 2 * DFF, 32 * sl, rowmap(1, nb) + 32 * (sl & 3), ws + WS_W1IN, (float*)(ws + WS_COLSC1), red, sp2, threadIdx.x); }
                else if (sl < NS_F + NS_M) { const int t = sl - NS_F, nbr = t >> 2, nb = nbr + (nbr >= 32 ? 32 : 0);
                    slab32_quant_i8(args.in[I_MIXIN], args.in[I_MIXN], MIXC, 128 * nb + 32 * (t & 3), rowmap(2, nb) + 32 * (t & 3), ws + WS_WMIX, (float*)(ws + WS_COLSC3), red, sp2, threadIdx.x); }
                else if (sl < 2 * NS_F + NS_M) { const int t = sl - NS_F - NS_M, nb = t >> 2;
                    slab32_quant_i8(args.in[I_F2IN], args.in[I_F2N], 2 * DFF, 32 * t, rowmap(1, nb) + 32 * (t & 3), ws + WS_W2IN, (float*)(ws + WS_COLSC2), red, sp2, threadIdx.x); }
                else if (sl < 2 * NS_F + NS_M + DM / 32) { const int t = sl - 2 * NS_F - NS_M;
                    slab32_quant_i8<false>(args.in[I_WK], nullptr, DM, 32 * t, 32 * t, ws + WS_WK, (float*)(ws + WS_COLSC4), red, sp2, threadIdx.x); }
                else { const int t = sl - 2 * NS_F - NS_M - DM / 32;
                    slab32_quant_i8<false>(args.in[I_WV], nullptr, DM, 32 * t, DM + 32 * t, ws + WS_WK, (float*)(ws + WS_COLSC4), red, sp2, threadIdx.x); }
            }
            __syncthreads();
        }
        constexpr int NITEMS = 2 * I_FOUT + I_MXB + I_GLU + I_CO + (MK_I8_KV ? 2 : 4) * I_SQ;
        for (int it = gw; it < NITEMS; it += NGW) {
            int r = it;
            if (r < I_FOUT) { p0_item(args.in[I_F1OUT], nullptr, DFF, DM, (bf16*)(ws + WS_W1OUT), 0, scr, r, lane); continue; } r -= I_FOUT;
            if (!MK_I8_KV) { if (r < I_SQ) { p0_item(args.in[I_WK], nullptr, DM, DM, (bf16*)(ws + WS_WK), 0, scr, r, lane); continue; } r -= I_SQ;
                             if (r < I_SQ) { p0_item(args.in[I_WV], nullptr, DM, DM, (bf16*)(ws + WS_WV), 0, scr, r, lane); continue; } r -= I_SQ; }
            if (r < I_SQ) { p0_item(args.in[I_WO], nullptr, DM, DM, (bf16*)(ws + WS_WO), 0, scr, r, lane); continue; } r -= I_SQ;
            if (r < I_MXB) { p0_item(args.in[I_MIXIN], args.in[I_MIXN], DM, MIXC, (bf16*)(ws + WS_WMIX + 32 * MiB), 2, scr, r, lane, 32, 32); continue; } r -= I_MXB;
            if (r < I_GLU) { p0_item(args.in[I_GLUW], nullptr, DSSM, 2 * DM, (bf16*)(ws + WS_WGLU), 3, scr, r, lane); continue; } r -= I_GLU;
            if (r < I_CO) { p0_item(args.in[I_CONVOUT], nullptr, DCONV, DM, (bf16*)(ws + WS_WCOUT), 0, scr, r, lane); continue; } r -= I_CO;
            if (r < I_SQ) { p0_item(args.in[I_MIXOUT], nullptr, DM, DM, (bf16*)(ws + WS_WMO), 0, scr, r, lane); continue; } r -= I_SQ;
            p0_item(args.in[I_F2OUT], nullptr, DFF, DM, (bf16*)(ws + WS_W2OUT), 0, scr, r, lane);
        }
#else
        constexpr int NITEMS = ((MK_I8_FFN & 1) ? I_CM : I_FIN) + ((MK_I8_FFN & 2) ? I_CM : I_FIN) + 2 * I_FOUT + (MK_I8_MIX ? I_CMX + I_MXB : (MK_FP8_GATES ? I_MIX + I_MIX8 : 2 * I_MIX)) + I_GLU + I_CO + 4 * I_SQ;
        for (int it = gw; it < NITEMS; it += NGW) {
            int r = it;
            if (MK_I8_FFN & 1) { if (r < I_CM) { p0_colmax_item(args.in[I_F1IN], args.in[I_F1N], 2 * DFF, 1, (unsigned*)(ctl + CW_COLMAX), r, lane); continue; } r -= I_CM; }
            else { if (r < I_FIN) { p0_item(args.in[I_F1IN], args.in[I_F1N], DM, 2 * DFF, (bf16*)(ws + WS_W1IN), 1, scr, r, lane); continue; } r -= I_FIN; }
            if (r < I_FOUT) { p0_item(args.in[I_F1OUT], nullptr, DFF, DM, (bf16*)(ws + WS_W1OUT), 0, scr, r, lane); continue; } r -= I_FOUT;
#if MK_I8_MIX
            if (r < I_CMX) { p0_colmax_item(args.in[I_MIXIN], args.in[I_MIXN], MIXC, 2, (unsigned*)(ctl + CW_COLMAX) + 4 * DFF, r, lane, true); continue; } r -= I_CMX;
            if (r < I_MXB) { p0_item(args.in[I_MIXIN], args.in[I_MIXN], DM, MIXC, (bf16*)(ws + WS_WMIX + 32 * MiB), 2, scr, r, lane, 32, 32); continue; } r -= I_MXB;
#elif MK_FP8_GATES
            if (r < I_MIX) { p0_item(args.in[I_MIXIN], args.in[I_MIXN], DM, MIXC, (bf16*)(ws + WS_WMIX), 2, scr, r, lane, 64); continue; } r -= I_MIX;
            if (r < I_MIX8) { p0_item8(args.in[I_MIXIN], args.in[I_MIXN], 256.0f, DM, MIXC, 8192, 64, ws + WS_WMIX8, scr, r, lane); continue; } r -= I_MIX8;
#else
            if (r < 2 * I_MIX) { p0_item(args.in[I_MIXIN], args.in[I_MIXN], DM, MIXC, (bf16*)(ws + WS_WMIX), 2, scr, r, lane); continue; } r -= 2 * I_MIX;
#endif
            if (r < I_GLU) { p0_item(args.in[I_GLUW], nullptr, DSSM, 2 * DM, (bf16*)(ws + WS_WGLU), 3, scr, r, lane); continue; } r -= I_GLU;
            if (r < I_CO) { p0_item(args.in[I_CONVOUT], nullptr, DCONV, DM, (bf16*)(ws + WS_WCOUT), 0, scr, r, lane); continue; } r -= I_CO;
            if (r < I_SQ) { p0_item(args.in[I_MIXOUT], nullptr, DM, DM, (bf16*)(ws + WS_WMO), 0, scr, r, lane); continue; } r -= I_SQ;
            if (r < I_SQ) { p0_item(args.in[I_WK], nullptr, DM, DM, (bf16*)(ws + WS_WK), 0, scr, r, lane); continue; } r -= I_SQ;
            if (r < I_SQ) { p0_item(args.in[I_WV], nullptr, DM, DM, (bf16*)(ws + WS_WV), 0, scr, r, lane); continue; } r -= I_SQ;
            if (r < I_SQ) { p0_item(args.in[I_WO], nullptr, DM, DM, (bf16*)(ws + WS_WO), 0, scr, r, lane); continue; } r -= I_SQ;
            if (MK_I8_FFN & 2) { if (r < I_CM) { p0_colmax_item(args.in[I_F2IN], args.in[I_F2N], 2 * DFF, 1, (unsigned*)(ctl + CW_COLMAX) + 2 * DFF, r, lane); continue; } r -= I_CM; }
            else { if (r < I_FIN) { p0_item(args.in[I_F2IN], args.in[I_F2N], DM, 2 * DFF, (bf16*)(ws + WS_W2IN), 1, scr, r, lane); continue; } r -= I_FIN; }
            p0_item(args.in[I_F2OUT], nullptr, DFF, DM, (bf16*)(ws + WS_W2OUT), 0, scr, r, lane);
        }
#endif
        if (MK_I8_FFN & 1) { for (int m = gw; m < MTOK; m += NGW) row_quant_i8(args.in[I_X] + (size_t)m * DM, MK_XF32 ? (bf16*)nullptr : xb + (size_t)m * DM, ws + WS_XB8 + (size_t)m * DM, (float*)(ws + WS_ROWFAC) + m, lane); }
        else for (int m = gw; m < MTOK; m += NGW) row_to_bf16(args.in[I_X] + (size_t)m * DM, xb + (size_t)m * DM, stats + (size_t)m * 64, nullptr, lane);
        for (int m = gw; m < DM; m += NGW) row_scale_to_bf16(args.in[I_WQ] + (size_t)m * DM, (bf16*)(ws + WS_WQ) + (size_t)m * DM, args.in[I_XN][m], lane);
        if ((MK_SLABQ & MK_I8_KV) != 0) { for (int m = gw; m < MMEM; m += NGW) row_norm_quant_i8(args.in[I_MEM] + (size_t)m * DM, args.in[I_MEMN], ws + WS_MEMN + (size_t)m * DM, (float*)(ws + WS_ROWFACM) + m, lane); }
        else for (int m = gw; m < MMEM; m += NGW) row_to_bf16(args.in[I_MEM] + (size_t)m * DM, (bf16*)(ws + WS_MEMN) + (size_t)m * DM, nullptr, args.in[I_MEMN], lane);
        {
            float* LAM = (float*)(ws + WS_SSMC); bf16* BFR = (bf16*)(ws + WS_SSMC + 128 * 1024); bf16* CFR = (bf16*)(ws + WS_SSMC + 1152 * 1024);
            const int gt = bid * (NWAVES * 64) + tid, NT = G * NWAVES * 64;
            for (int i = gt; i < NG * GP; i += NT) { const int g = i / GP;
                const double dt = exp((double)args.in[I_LOGDT][g]), ar = (double)args.in[I_ARE][i] * dt, ai = (double)args.in[I_AIM][i] * dt, e = exp(ar);
                LAM[2 * i] = (float)(e * cos(ai)); LAM[2 * i + 1] = (float)(e * sin(ai)); }
            for (int i = gt; i < NG * 8 * 64 * 8; i += NT) { const int j = i & 7, ln = (i >> 3) & 63, mt = (i >> 9) & 7, g = i >> 12; const int q = ln >> 4, pp = 16 * mt + (ln & 15), p = pp >> 1, c = pp & 1;
                float val = 0.f;
                if (q < 2) { const int h = 8 * q + j; const int ip = g * GP + p;
                    const double dt = exp((double)args.in[I_LOGDT][g]), lr = (double)args.in[I_ARE][ip], li = (double)args.in[I_AIM][ip], e = exp(lr * dt);
                    const double zr = e * cos(li * dt) - 1.0, zi = e * sin(li * dt), den = lr * lr + li * li;
                    const double fr_ = (zr * lr + zi * li) / den, fi_ = (zi * lr - zr * li) / den;
                    const double br = (double)args.in[I_BRE][(size_t)ip * GH + h], bi = (double)args.in[I_BIM][(size_t)ip * GH + h];
                    val = (float)(c == 0 ? (fr_ * br - fi_ * bi) : (fr_ * bi + fi_ * br)); }
                BFR[i] = (bf16)f2bf(val); }
            for (int i = gt; i < NG * 4 * 64 * 8; i += NT) { const int j = i & 7, ln = (i >> 3) & 63, ks = (i >> 9) & 3, g = i >> 11; const int q = ln >> 4, o = ln & 15, pp = 32 * ks + 8 * q + j, p = pp >> 1;
                const size_t ic = ((size_t)g * GH + o) * GP + p;
                CFR[i] = (bf16)f2bf((pp & 1) ? -args.in[I_CIM][ic] : args.in[I_CRE][ic]); }
        }
    }
#if !MK_SLABQ
    SEAM(0);
#endif

    if (IN(1) && !MK_SLABQ) {
        FRESH_IDS();
        LAS unsigned* scr = (LAS unsigned*)(lds + wave * 16896);
        constexpr int I_Q = (DM / 128) * (2 * DFF / 128);
        constexpr int I_QM = (DM / 128) * (MIXC / 128 - 32);
        for (int it = gw; it < ((MK_I8_FFN & 1) ? I_Q : 0) + ((MK_I8_FFN & 2) ? I_Q : 0) + (MK_I8_MIX ? I_QM : 0); it += NGW) {
            int r = it;
            if (MK_I8_FFN & 1) { if (r < I_Q) { p0_item_i8(args.in[I_F1IN], args.in[I_F1N], DM, 2 * DFF, 1, (const unsigned*)(ctl + CW_COLMAX), (float*)(ws + WS_COLSC1), ws + WS_W1IN, scr, r, lane); continue; } r -= I_Q; }
            if (MK_I8_MIX) { if (r < I_QM) { p0_item_i8(args.in[I_MIXIN], args.in[I_MIXN], DM, MIXC, 2, (const unsigned*)(ctl + CW_COLMAX) + 4 * DFF, (float*)(ws + WS_COLSC3), ws + WS_WMIX, scr, r, lane, true); continue; } r -= I_QM; }
            if (MK_I8_FFN & 2) p0_item_i8(args.in[I_F2IN], args.in[I_F2N], DM, 2 * DFF, 1, (const unsigned*)(ctl + CW_COLMAX) + 2 * DFF, (float*)(ws + WS_COLSC2), ws + WS_W2IN, scr, r, lane);
        }
    }
    SEAM(1);

    if (IN(2)) {
        pg8::StaticOrder S; S.init(MTOK, 2 * DFF, G, bid); pg8::Unit u0;
#if MK_I8_FFN & 1
        if (S.next(0, u0) && threadIdx.x < 256) rstd_tab[threadIdx.x] = ((const float*)(ws + WS_ROWFAC))[u0.pm * 256 + threadIdx.x];
        __syncthreads();
        { pg8::AddrStd AD{(const char*)(ws + WS_XB8), (const char*)(ws + WS_W1IN), 256u * DM, 256u * DM};
          pg8::EpiSwigluI8 E{(bf16*)(big + BG_HID), DFF, rstd_tab, (const float*)(ws + WS_COLSC1)};
          pg8::gemm_phase<2>(lds, DM / 2, DM / 2, DM / 2, AD, S, E); }
#else
        if (S.next(0, u0)) rstd_table(stats, u0.pm, rstd_tab); else __syncthreads();
        { pg8::AddrStd AD{(const char*)xb, (const char*)(ws + WS_W1IN), 256u * DM * 2u, 256u * DM * 2u};
          pg8::EpiSwiglu E{(bf16*)(big + BG_HID), DFF, rstd_tab};
          pg8::gemm_phase(lds, DM, DM, DM, AD, S, E); }
#endif
        { const bool tail = (G == 256); pg8::StaticOrder S2; S2.init(MMEM, 2 * DM, tail ? 128 : G, tail ? bid - 128 : bid);
          if (!tail || bid >= 128) {
#if MK_SLABQ && MK_I8_KV
              pg8::AddrStd AD{(const char*)(ws + WS_MEMN), (const char*)(ws + WS_WK), 256u * DM, 256u * DM};
              pg8::EpiBf16I8 E{(bf16*)(ws + WS_KV), 2 * DM, (const float*)(ws + WS_ROWFACM), (const float*)(ws + WS_COLSC4)};
              pg8::gemm_phase<2>(lds, DM / 2, DM / 2, DM / 2, AD, S2, E); } }
#else
              pg8::AddrStd AD{(const char*)(ws + WS_MEMN), (const char*)(ws + WS_WK), 256u * DM * 2u, 256u * DM * 2u};
              pg8::EpiBf16 E{(bf16*)(ws + WS_KV), 2 * DM, nullptr, 1.0f};
              pg8::gemm_phase(lds, DM, DM, DM, AD, S2, E); } }
#endif
    }
    SEAM(2);

    if (IN(3)) {
        pg8::AddrStd AD{(const char*)(big + BG_HID), (const char*)(ws + WS_W1OUT), 256u * DFF * 2u, 256u * DFF * 2u};
        pg8::EpiRes<true, true, true, (MK_FP8_GATES != 0 && !MK_I8_MIX), false, false, (MK_XF32 != 0 && (MK_I8_FFN & 1) != 0)> E{nullptr, xb, stats, ws + WS_XB8, args.in[I_X]};
        if (G == 256) { pg8::PanelOrder S; S.init(MTOK, DM, G, bid); pg8::gemm_phase(lds, DFF, DFF, DFF, AD, S, E); }
        else { pg8::StaticOrder S; S.init(MTOK, DM, G, bid); pg8::gemm_phase(lds, DFF, DFF, DFF, AD, S, E); }
        { pg8::StaticOrder S2; S2.init(DM, DM, G, bid); pg8::AddrQK AD2{(const char*)(ws + WS_KV), (const char*)(ws + WS_WQ)};
#if MK_FP8_ATTN
          pg8::EpiFp8 E2{ws + WS_WQK, DM, 1.0f}; pg8::gemm_phase(lds, HD, 2 * DM, DM, AD2, S2, E2); }
#else
          pg8::EpiBf16 E2{(bf16*)(ws + WS_WQK), DM, nullptr, 1.0f}; pg8::gemm_phase(lds, HD, 2 * DM, DM, AD2, S2, E2); }
#endif
        { pg8::StaticOrder S3; S3.init(DM, DM, G, bid); pg8::AddrVO AD3{(const char*)(ws + WS_WO), (const char*)(ws + WS_KV)};
#if MK_FP8_ATTN
          pg8::EpiFp8 E3{ws + WS_WVO, DM, 1.0f}; pg8::gemm_phase(lds, HD, DM, 2 * DM, AD3, S3, E3); }
#else
          pg8::EpiBf16 E3{(bf16*)(ws + WS_WVO), DM, nullptr, 1.0f}; pg8::gemm_phase(lds, HD, DM, 2 * DM, AD3, S3, E3); }
#endif
    }
    SEAM(3);

    if (IN(4)) {
        FRESH_IDS();
        if (MK_I8_MIX) for (int m = gw; m < MTOK; m += NGW) row_quant_bf16_i8(xb + (size_t)m * DM, stats + (size_t)m * 64, ws + WS_XB8 + (size_t)m * DM, (float*)(ws + WS_ROWFAC) + m, lane);
    }
    SEAM(4);

    if (IN(5)) {
#if MK_I8_MIX
        pg8::StaticOrder S; S.init(MTOK, DM, G, bid); pg8::Unit u0; const bool has = S.next(0, u0);
        if (has) rstd_table(stats, u0.pm, rstd_tab); else __syncthreads();
        { pg8::AddrStd AD{(const char*)xb, (const char*)(ws + WS_WMIX + 64 * MiB), 256u * DM * 2u, 256u * DM * 2u};
          pg8::EpiZc E{(bf16*)(big + BG_ZC), rstd_tab};
          pg8::gemm_phase(lds, DM, DM, DM, AD, S, E); }
        __syncthreads();
        if (has && threadIdx.x < 256) rstd_tab[threadIdx.x] = ((const float*)(ws + WS_ROWFAC))[u0.pm * 256 + threadIdx.x];
        __syncthreads();
        { pg8::StaticOrder S2; S2.init(MTOK, MIXC - DM, G, bid);
          pg8::AddrMixI8 AD{(const char*)(ws + WS_XB8), (const char*)(ws + WS_WMIX), 256u * DM, 256u * DM};
          pg8::EpiMixI8 E{(bf16*)(big + BG_USSM), (bf16*)(big + BG_CB), (bf16*)(big + BG_GA), (bf16*)(big + BG_GB), rstd_tab, (const float*)(ws + WS_COLSC3)};
          pg8::gemm_phase<2>(lds, DM / 2, DM / 2, DM / 2, AD, S2, E); }
#elif MK_FP8_GATES
        pg8::StaticOrder S; S.init(MTOK, MIXC / 2, G, bid); pg8::Unit u0;
        if (S.next(0, u0)) rstd_table(stats, u0.pm, rstd_tab); else __syncthreads();
        { pg8::AddrStd AD{(const char*)xb, (const char*)(ws + WS_WMIX), 256u * DM * 2u, 256u * DM * 2u};
          pg8::EpiMix E{(bf16*)(big + BG_USSM), (bf16*)(big + BG_CB), (bf16*)(big + BG_ZC), (bf16*)(big + BG_GA), (bf16*)(big + BG_GB), rstd_tab};
          pg8::gemm_phase(lds, DM, DM, DM, AD, S, E); }
        { pg8::AddrStd AD{(const char*)(ws + WS_XB8), (const char*)(ws + WS_WMIX8), 256u * DM, 256u * DM};
          pg8::EpiGate8 E{(bf16*)(big + BG_GA), (bf16*)(big + BG_GB), rstd_tab};
          pg8::gemm_phase<1>(lds, DM / 2, DM / 2, DM / 2, AD, S, E); }
#else
        pg8::StaticOrder S; S.init(MTOK, MIXC, G, bid); pg8::Unit u0;
        if (S.next(0, u0)) rstd_table(stats, u0.pm, rstd_tab); else __syncthreads();
        pg8::AddrStd AD{(const char*)xb, (const char*)(ws + WS_WMIX), 256u * DM * 2u, 256u * DM * 2u};
        pg8::EpiMix E{(bf16*)(big + BG_USSM), (bf16*)(big + BG_CB), (bf16*)(big + BG_ZC), (bf16*)(big + BG_GA), (bf16*)(big + BG_GB), rstd_tab};
        pg8::gemm_phase(lds, DM, DM, DM, AD, S, E);
#endif
    }

    SEAM(5);

    if (IN(6)) {
        FRESH_IDS();
        const bf16* ussm = (const bf16*)(big + BG_USSM);
        constexpr int NA = NB * NG * (SSM_NSEG - 1);
        if (gw < NA) { const int g = gw & 127, bs = gw >> 7;
            ssm_unit<false>(lds + wave * 12800, ws, ussm, (bf16*)(ws + WS_YS), args.in[I_SSMD], bs / (SSM_NSEG - 1), g, bs % (SSM_NSEG - 1), lane); }
        {
            const bool split = NGW > NA;
            const int cw = split ? gw - NA : gw, ncw = split ? NGW - NA : NGW;
            if (cw >= 0) {
                const bf16* zc = (const bf16*)(big + BG_ZC); const bf16* cbp = (const bf16*)(big + BG_CB); bf16* ycv = (bf16*)(ws + WS_YCV);
                for (int cu = cw; cu < (MTOK / 64) * 4; cu += ncw) {
                    const int seg = cu >> 2, ch0 = (cu & 3) * 512 + lane * 8, t0 = seg * 64;
                    float w0[8], w1[8], w2[8];
#pragma unroll
                    for (int j = 0; j < 8; ++j) { w0[j] = args.in[I_CONVW][ch0 + j]; w1[j] = args.in[I_CONVW][DCONV + ch0 + j]; w2[j] = args.in[I_CONVW][2 * DCONV + ch0 + j]; }
                    u32x4 z2 = {0u, 0u, 0u, 0u}, z1 = {0u, 0u, 0u, 0u};
                    if ((t0 & (SEQ - 1)) != 0) { z2 = *(const GAS u32x4*)(zc + (size_t)(t0 - 2) * DCONV + ch0); z1 = *(const GAS u32x4*)(zc + (size_t)(t0 - 1) * DCONV + ch0); }
#pragma unroll 4
                    for (int t = t0; t < t0 + 64; ++t) {
                        const u32x4 z0 = *(const GAS u32x4*)(zc + (size_t)t * DCONV + ch0), cbv = *(const GAS u32x4*)(cbp + (size_t)t * DCONV + ch0);
                        const unsigned a2[4] = {z2.x, z2.y, z2.z, z2.w}, a1[4] = {z1.x, z1.y, z1.z, z1.w}, a0[4] = {z0.x, z0.y, z0.z, z0.w}, cc[4] = {cbv.x, cbv.y, cbv.z, cbv.w}; unsigned ow[4];
#pragma unroll
                        for (int h = 0; h < 4; ++h) {
                            const float e = bf_lo(cc[h]) * (w0[2 * h] * bf_lo(a2[h]) + w1[2 * h] * bf_lo(a1[h]) + w2[2 * h] * bf_lo(a0[h]));
                            const float o = bf_hi(cc[h]) * (w0[2 * h + 1] * bf_hi(a2[h]) + w1[2 * h + 1] * bf_hi(a1[h]) + w2[2 * h + 1] * bf_hi(a0[h]));
                            ow[h] = pk2(e, o); }
                        u32x4 w; w.x = ow[0]; w.y = ow[1]; w.z = ow[2]; w.w = ow[3];
                        *(GAS u32x4*)(ycv + (size_t)t * DCONV + ch0) = w;
                        z2 = z1; z1 = z0;
                    }
                }
            }
        }
    }
    SEAM(6);

    if (IN(7)) {
        FRESH_IDS();
        const bf16* ussm = (const bf16*)(big + BG_USSM);
        for (int un = gw; un < NB * NG * SSM_NSEG; un += NGW) { const int g = un & 127, bs = un >> 7;
            ssm_unit<true>(lds + wave * 12800, ws, ussm, (bf16*)(ws + WS_YS), args.in[I_SSMD], bs / SSM_NSEG, g, bs % SSM_NSEG, lane); }
    }
    SEAM(7);

    if (IN(8)) {
        pg8::StaticOrder S; S.init(MTOK, DM, G, bid);
        pg8::AddrStd AD{(const char*)(ws + WS_YCV), (const char*)(ws + WS_WCOUT), 256u * DCONV * 2u, 256u * DCONV * 2u};
        pg8::EpiConvOut E{(const bf16*)(big + BG_GB), (bf16*)(big + BG_TMP)};
        pg8::gemm_phase(lds, DCONV, DCONV, DCONV, AD, S, E);
    }
    SEAM(8);

    if (IN(9)) {
        pg8::StaticOrder S; S.init(MTOK, 2 * DM, G, bid);
        pg8::AddrStd AD{(const char*)(ws + WS_YS), (const char*)(ws + WS_WGLU), 256u * DSSM * 2u, 256u * DSSM * 2u};
        pg8::EpiGlu E{(const bf16*)(big + BG_GA), (bf16*)(big + BG_TMP)};
        pg8::gemm_phase(lds, DSSM, DSSM, DSSM, AD, S, E);
    }
    SEAM(9);

    if (IN(10)) {
        pg8::StaticOrder S; S.init(MTOK, DM, G, bid);
        pg8::AddrStd AD{(const char*)(big + BG_TMP), (const char*)(ws + WS_WMO), 256u * DM * 2u, 256u * DM * 2u};
        pg8::EpiRes<true, true, false, MK_FP8_ATTN != 0> E{nullptr, xb, stats, ws + WS_XB8};
        pg8::gemm_phase(lds, DM, DM, DM, AD, S, E);
    }
    SEAM(10);

    if (IN(11)) {
        pg8::StaticOrder S; S.init(MTOK, NH * NMEM, G, bid); pg8::Unit u0;
        if (S.next(0, u0)) rstd_table(stats, u0.pm, rstd_tab); else __syncthreads();
#if MK_FP8_ATTN
        pg8::AddrSc8 AD{(const char*)(ws + WS_XB8), (const char*)(ws + WS_WQK)};
        pg8::EpiSoftmax<true> E{(bf16*)(big + BG_P), rstd_tab, (LAS float*)(lds + XCH_OFF), 0.03125f * 1.4426950408889634f};
        pg8::gemm_phase<1>(lds, DM / 2, DM / 2, DM / 2, AD, S, E);
#else
        pg8::AddrSc AD{(const char*)xb, (const char*)(ws + WS_WQK)};
        pg8::EpiSoftmax<false> E{(bf16*)(big + BG_P), rstd_tab, (LAS float*)(lds + XCH_OFF), 0.03125f * 1.4426950408889634f};
        pg8::gemm_phase(lds, DM, DM, DM, AD, S, E);
#endif
    }
    SEAM(11);

    if (IN(12)) {
        pg8::StaticOrder S; S.init(MTOK, DM, G, bid);
#if MK_FP8_ATTN
        pg8::AddrAO8 AD{(const char*)(big + BG_P), (const char*)(ws + WS_WVO)};
        pg8::EpiRes<true, true, false, false, false, true> E{nullptr, xb, stats, nullptr};
        pg8::gemm_phase<1>(lds, NH * NMEM / 2, NH * NMEM / 2, DM / 2, AD, S, E);
#else
        pg8::AddrAO AD{(const char*)(big + BG_P), (const char*)(ws + WS_WVO)};
        pg8::EpiRes<true, true, false> E{nullptr, xb, stats, nullptr};
        pg8::gemm_phase(lds, NH * NMEM, NH * NMEM, DM, AD, S, E);
#endif
    }
    SEAM(12);

    if (IN(13)) {
        FRESH_IDS();
        if (MK_I8_FFN & 2) for (int m = gw; m < MTOK; m += NGW) row_quant_bf16_i8(xb + (size_t)m * DM, stats + (size_t)m * 64, ws + WS_XB8 + (size_t)m * DM, (float*)(ws + WS_ROWFAC) + m, lane);
    }
    SEAM(13);

    if (IN(14)) {
        pg8::StaticOrder S; S.init(MTOK, 2 * DFF, G, bid); pg8::Unit u0;
#if MK_I8_FFN & 2
        if (S.next(0, u0) && threadIdx.x < 256) rstd_tab[threadIdx.x] = ((const float*)(ws + WS_ROWFAC))[u0.pm * 256 + threadIdx.x];
        __syncthreads();
        pg8::AddrStd AD{(const char*)(ws + WS_XB8), (const char*)(ws + WS_W2IN), 256u * DM, 256u * DM};
        pg8::EpiSwigluI8 E{(bf16*)(big + BG_HID), DFF, rstd_tab, (const float*)(ws + WS_COLSC2)};
        pg8::gemm_phase<2>(lds, DM / 2, DM / 2, DM / 2, AD, S, E);
#else
        if (S.next(0, u0)) rstd_table(stats, u0.pm, rstd_tab); else __syncthreads();
        pg8::AddrStd AD{(const char*)xb, (const char*)(ws + WS_W2IN), 256u * DM * 2u, 256u * DM * 2u};
        pg8::EpiSwiglu E{(bf16*)(big + BG_HID), DFF, rstd_tab};
        pg8::gemm_phase(lds, DM, DM, DM, AD, S, E);
#endif
    }
    SEAM(14);

    if (IN(15)) {
        pg8::AddrStd AD{(const char*)(big + BG_HID), (const char*)(ws + WS_W2OUT), 256u * DFF * 2u, 256u * DFF * 2u};
        pg8::EpiRes<true, false, true> E{nullptr, xb, nullptr, nullptr};
        if (G == 256) { pg8::PanelOrder S; S.init(MTOK, DM, G, bid); pg8::gemm_phase(lds, DFF, DFF, DFF, AD, S, E); }
        else { pg8::StaticOrder S; S.init(MTOK, DM, G, bid); pg8::gemm_phase(lds, DFF, DFF, DFF, AD, S, E); }
    }
    SEAM(15);

    if (IN(16)) {
        FRESH_IDS();
        const float* gf = args.in[I_FINN];
        for (int m = gw; m < MTOK; m += NGW) {
            const GAS u32x2* xr = (const GAS u32x2*)(xb + (size_t)m * DM) + lane; GAS f32x4* orow = (GAS f32x4*)(hres + (size_t)m * DM) + lane;
            f32x4 v[16]; float s = 0.f;
#pragma unroll
            for (int j = 0; j < 16; ++j) { const u32x2 w = xr[64 * j]; v[j] = (f32x4){bf_lo(w.x), bf_hi(w.x), bf_lo(w.y), bf_hi(w.y)}; s += (v[j].x * v[j].x + v[j].y * v[j].y) + (v[j].z * v[j].z + v[j].w * v[j].w); }
            const float sc = 1.0f / sqrtf(wave_sum(s) * (1.0f / DM) + RMS_EPS);
#pragma unroll
            for (int j = 0; j < 16; ++j) { const f32x4 g = ((const GAS f32x4*)gf)[lane + 64 * j]; orow[64 * j] = v[j] * sc * g; }
        }
    }
#undef IN
#undef SEAM
}

extern "C" void kernel_launch(void* const* d_in, const int* in_sizes, int n_in, void* d_out, int out_size, void* d_ws, size_t ws_size, hipStream_t stream) {
    static int grid = 0;
    if (grid == 0) {
        if (n_in != 29 || in_sizes[0] != MTOK * DM || out_size != MTOK * DM || ws_size < WS_END) {
            fprintf(stderr, "kernel_launch: unexpected shapes / workspace (n_in %d, in0 %d, out %d, ws %zu, need %zu)\n", n_in, n_in > 0 ? in_sizes[0] : -1, out_size, ws_size, (size_t)WS_END); grid = -1; return; }
        int dev = 0, cus = 0, per_cu = 0;
        if (hipGetDevice(&dev) != hipSuccess || hipDeviceGetAttribute(&cus, hipDeviceAttributeMultiprocessorCount, dev) != hipSuccess) { grid = -1; return; }
        if (hipFuncSetAttribute((const void*)mk_fwd, hipFuncAttributeMaxDynamicSharedMemorySize, LDS_BYTES) != hipSuccess) { grid = -1; return; }
        if (hipOccupancyMaxActiveBlocksPerMultiprocessor(&per_cu, (const void*)mk_fwd, NWAVES * 64, LDS_BYTES) != hipSuccess || per_cu < 1)
            fprintf(stderr, "kernel_launch: occupancy query reports %d workgroups per CU\n", per_cu);
        (void)hipGetLastError();
        grid = cus;
    }
    if (grid < 0) return;
    if (hipMemsetAsync((char*)d_ws + WS_CTL, 0, CTL_ZERO_BYTES, stream) != hipSuccess) return;
    Args a{};
    for (int i = 0; i < 29; ++i) a.in[i] = (const float*)d_in[i];
    a.out = (float*)d_out; a.ws = (unsigned char*)d_ws;
#if MK_ONE_LAUNCH
    a.ph_lo = 0; a.ph_hi = NPHASE;
    hipLaunchKernelGGL(mk_fwd, dim3(grid), dim3(NWAVES * 64), LDS_BYTES, stream, a);
#else
    for (int p = 0; p < NPHASE; ++p) { a.ph_lo = p; a.ph_hi = p + 1; hipLaunchKernelGGL(mk_fwd, dim3(grid), dim3(NWAVES * 64), LDS_BYTES, stream, a); }
#endif
}
```
